# Optimizing an MI355X kernel written in HIP

```python
import math
import jax, jax.numpy as jnp
from jax import lax
import numpy as np

D_MODEL = 2048
BATCH = 1
SEQ = 16384
DEPTH = 4

GRID_W = 64
CTX_LEN = 256
Q_BLOCK = 128
RET_CHUNK = 128
ROPE_THETA = 10000.0
EPS = 1e-6

A_WIDTH = D_MODEL // 2
A_HEADS = 8
A_HEAD_DIM = A_WIDTH // A_HEADS // 2
A_V_DIM = 2 * A_HEAD_DIM
A_QK_WIDTH = 2 * A_HEADS * A_HEAD_DIM
B_WIDTH = D_MODEL - A_WIDTH
B_HEADS = 4
B_V_DIM = B_WIDTH // B_HEADS
B_K_DIM = B_V_DIM // 2
B_QK_WIDTH = B_HEADS * B_K_DIM
EV_SIZES = (A_QK_WIDTH, A_QK_WIDTH, A_WIDTH, A_WIDTH, B_QK_WIDTH, B_QK_WIDTH, B_WIDTH, B_WIDTH)
EV_IN = sum(EV_SIZES)
EV_MIX = A_WIDTH + B_WIDTH

C_HEADS = 16
C_KV_HEADS = 4
C_GROUP = C_HEADS // C_KV_HEADS
C_HEAD_DIM = D_MODEL // C_HEADS
C_WIDTH = C_HEADS * C_HEAD_DIM
C_KV_WIDTH = C_KV_HEADS * C_HEAD_DIM
OD_SIZES = (C_WIDTH, C_KV_WIDTH, C_KV_WIDTH, C_WIDTH)
OD_IN = sum(OD_SIZES)

N_EVEN = (DEPTH + 1) // 2
N_ODD = DEPTH // 2

kernel_name = 'hybrid_diffattn_retention_gqa_dit'


def rms_norm(x, g):
    x32 = x.astype(jnp.float32)
    y = x32 * lax.rsqrt(jnp.mean(x32 * x32, axis=-1, keepdims=True) + EPS)
    return y.astype(x.dtype) * g


def group_norm(x, g):
    x32 = x.astype(jnp.float32)
    mu = jnp.mean(x32, axis=-1, keepdims=True)
    xc = x32 - mu
    y = xc * lax.rsqrt(jnp.mean(xc * xc, axis=-1, keepdims=True) + EPS)
    return y.astype(x.dtype) * g


def split_sizes(t, sizes):
    idx, acc = [], 0
    for s in sizes[:-1]:
        acc += s
        idx.append(acc)
    return jnp.split(t, idx, axis=-1)


def to_heads(t, n_heads):
    b, l, _ = t.shape
    return t.reshape(b, l, n_heads, -1).transpose(0, 2, 1, 3)


def merge_heads(t):
    b, h, l, d = t.shape
    return t.transpose(0, 2, 1, 3).reshape(b, l, h * d)


def grid_positions(n_lat):
    n_rows = n_lat // GRID_W
    rows = jnp.broadcast_to(jnp.arange(n_rows, dtype=jnp.int32)[:, None], (n_rows, GRID_W)).reshape(-1)
    cols = jnp.broadcast_to(jnp.arange(GRID_W, dtype=jnp.int32)[None, :], (n_rows, GRID_W)).reshape(-1)
    return rows, cols


def rope_tables(rows, cols, head_dim):
    axis_dim = head_dim // 2
    inv = ROPE_THETA ** (-jnp.arange(0, axis_dim, 2, dtype=jnp.float32) / axis_dim)
    ang_r = rows.astype(jnp.float32)[:, None] * inv
    ang_c = cols.astype(jnp.float32)[:, None] * inv
    return (jnp.cos(ang_r), jnp.sin(ang_r), jnp.cos(ang_c), jnp.sin(ang_c))


def _rotate(x, cos, sin):
    x1, x2 = jnp.split(x, 2, axis=-1)
    return jnp.concatenate([x1 * cos - x2 * sin, x1 * sin + x2 * cos], axis=-1)


def apply_rope_2d(x, tables):
    cr, sr, cc, sc = tables
    xr, xc = jnp.split(x, 2, axis=-1)
    return jnp.concatenate([_rotate(xr, cr, sr), _rotate(xc, cc, sc)], axis=-1).astype(x.dtype)


def _to_blocks(q):
    *lead, n, d = q.shape
    return jnp.moveaxis(q.reshape(*lead, n // Q_BLOCK, Q_BLOCK, d), -3, 0)


def _from_blocks(o):
    o = jnp.moveaxis(o, 0, -3)
    *lead, nb, qb, d = o.shape
    return o.reshape(*lead, nb * qb, d)


def diff_attn_core(q1, q2, k1, k2, v, lam):
    scale = A_HEAD_DIM ** -0.5
    s1 = jnp.einsum('bhqd,bhkd->bhqk', q1, k1) * scale
    s2 = jnp.einsum('bhqd,bhkd->bhqk', q2, k2) * scale
    p = jax.nn.softmax(s1.astype(jnp.float32), axis=-1) - lam * jax.nn.softmax(s2.astype(jnp.float32), axis=-1)
    return jnp.einsum('bhqk,bhke->bhqe', p.astype(v.dtype), v)


def gqa_core(q, k, v):
    s = jnp.einsum('bhgqd,bhkd->bhgqk', q, k) * (C_HEAD_DIM ** -0.5)
    p = jax.nn.softmax(s.astype(jnp.float32), axis=-1).astype(v.dtype)
    return jnp.einsum('bhgqk,bhkd->bhgqd', p, v)


def retention_chunkwise(q, k, v, log_g, s0):
    b, h, l, dk = q.shape
    dv = v.shape[-1]
    nc = l // RET_CHUNK
    dt = q.dtype
    qc = q.reshape(b, h, nc, RET_CHUNK, dk)
    kc = k.reshape(b, h, nc, RET_CHUNK, dk)
    vc = v.reshape(b, h, nc, RET_CHUNK, dv)
    pos = jnp.arange(RET_CHUNK, dtype=jnp.float32)
    lg = log_g.astype(jnp.float32)[:, None]
    rel = pos[:, None] - pos[None, :]
    decay = jnp.where(rel >= 0, jnp.exp(lg[:, :, None] * jnp.maximum(rel, 0.0)), 0.0)
    q_decay = jnp.exp(lg * (pos + 1.0))
    k_decay = jnp.exp(lg * (RET_CHUNK - 1.0 - pos))
    chunk_decay = jnp.exp(lg[:, 0] * RET_CHUNK).astype(dt)
    scores = jnp.einsum('bhnid,bhnjd->bhnij', qc, kc) * decay[None, :, None].astype(dt)
    intra = jnp.einsum('bhnij,bhnje->bhnie', scores, vc)
    upd = jnp.einsum('bhnjd,bhnje->nbhde', kc * k_decay[None, :, None, :, None].astype(dt), vc)

    def step(s, u):
        return s * chunk_decay[None, :, None, None] + u, s

    s_final, s_prev = lax.scan(step, s0, upd)
    cross = jnp.einsum('bhnid,nbhde->bhnie', qc * q_decay[None, :, None, :, None].astype(dt), s_prev)
    return (intra + cross).reshape(b, h, l, dv), s_final


def bi_retention(q_c, k_c, v_c, q_l, k_l, v_l, log_g_fwd, log_g_bwd):
    flip = lambda t: jnp.flip(t, axis=2)
    b, h, _, dk = q_c.shape
    s0 = jnp.zeros((b, h, dk, v_c.shape[-1]), q_c.dtype)
    o_cf, s_cf = retention_chunkwise(q_c, k_c, v_c, log_g_fwd, s0)
    o_cb, s_cb = retention_chunkwise(flip(q_c), flip(k_c), flip(v_c), log_g_bwd, s0)
    o_lf, _ = retention_chunkwise(q_l, k_l, v_l, log_g_fwd, s_cf)
    o_lb, _ = retention_chunkwise(flip(q_l), flip(k_l), flip(v_l), log_g_bwd, s_cb)
    return o_lf + flip(o_lb), o_cf + flip(o_cb)


def even_mixer(h_lat, h_ctx, w_in, w_out, lam_p, subln_g, ret_log_a, ret_g, rope_a, layer_idx, need_ctx):
    lambda_init = 0.8 - 0.6 * math.exp(-0.3 * layer_idx)
    lp = lam_p.astype(jnp.float32)
    lam = jnp.exp(jnp.sum(lp[0] * lp[1])) - jnp.exp(jnp.sum(lp[2] * lp[3])) + lambda_init
    log_g = -jnp.exp(ret_log_a.astype(jnp.float32))

    def project(h, rope):
        aq, ak, av, ag, bq, bk, bv, bg = split_sizes(h @ w_in, EV_SIZES)
        aq = to_heads(aq, 2 * A_HEADS)
        ak = to_heads(ak, 2 * A_HEADS)
        if rope is not None:
            aq = apply_rope_2d(aq, rope)
            ak = apply_rope_2d(ak, rope)
        b, _, l, _ = aq.shape
        aq = aq.reshape(b, A_HEADS, 2, l, A_HEAD_DIM)
        ak = ak.reshape(b, A_HEADS, 2, l, A_HEAD_DIM)
        return (aq[:, :, 0], aq[:, :, 1], ak[:, :, 0], ak[:, :, 1], to_heads(av, A_HEADS), ag,
                to_heads(bq, B_HEADS), to_heads(bk, B_HEADS) * (B_K_DIM ** -0.5), to_heads(bv, B_HEADS), bg)

    def finish(o_a, a_gate, o_b, b_gate):
        ya = merge_heads(rms_norm(o_a, subln_g) * (1.0 - lambda_init)) * jax.nn.silu(a_gate)
        yb = merge_heads(group_norm(o_b, ret_g[None, :, None, :])) * jax.nn.silu(b_gate)
        return jnp.concatenate([ya, yb], axis=-1) @ w_out

    lat = project(h_lat, rope_a)
    cx = project(h_ctx, None)
    k1_all = jnp.concatenate([cx[2], lat[2]], axis=2)
    k2_all = jnp.concatenate([cx[3], lat[3]], axis=2)
    v_all = jnp.concatenate([cx[4], lat[4]], axis=2)
    o_a_lat = _from_blocks(lax.map(lambda qs: diff_attn_core(qs[0], qs[1], k1_all, k2_all, v_all, lam),
                                   (_to_blocks(lat[0]), _to_blocks(lat[1]))))
    o_b_lat, o_b_ctx = bi_retention(cx[6], cx[7], cx[8], lat[6], lat[7], lat[8], log_g[0], log_g[1])
    y_lat = finish(o_a_lat, lat[5], o_b_lat, lat[9])
    y_ctx = None
    if need_ctx:
        o_a_ctx = diff_attn_core(cx[0], cx[1], cx[2], cx[3], cx[4], lam)
        y_ctx = finish(o_a_ctx, cx[5], o_b_ctx, cx[9])
    return y_lat, y_ctx


def odd_mixer(h_lat, h_ctx, w_in, w_out, qk_g, rope_c, need_ctx):
    def project(h, rope):
        q, k, v, g = split_sizes(h @ w_in, OD_SIZES)
        q = rms_norm(to_heads(q, C_HEADS), qk_g[0])
        k = rms_norm(to_heads(k, C_KV_HEADS), qk_g[1])
        if rope is not None:
            q = apply_rope_2d(q, rope)
            k = apply_rope_2d(k, rope)
        b, _, l, _ = q.shape
        return q.reshape(b, C_KV_HEADS, C_GROUP, l, C_HEAD_DIM), k, to_heads(v, C_KV_HEADS), g

    def finish(o, g):
        b, hk, gr, l, d = o.shape
        return (merge_heads(o.reshape(b, hk * gr, l, d)) * jax.nn.silu(g)) @ w_out

    ql, kl, vl, gl = project(h_lat, rope_c)
    qc, kc, vc, gc = project(h_ctx, None)
    k_all = jnp.concatenate([kc, kl], axis=2)
    v_all = jnp.concatenate([vc, vl], axis=2)
    o_lat = _from_blocks(lax.map(lambda qb: gqa_core(qb, k_all, v_all), _to_blocks(ql)))
    y_lat = finish(o_lat, gl)
    y_ctx = finish(gqa_core(qc, kc, vc), gc) if need_ctx else None
    return y_lat, y_ctx


def setup_inputs(seed: int = 0) -> dict:
    key = jax.random.key(seed)
    ks = jax.random.split(key, 20)
    f32 = jnp.float32
    nrm = lambda k, shape, s: jax.random.normal(k, shape, f32) * s
    heads = jnp.arange(B_HEADS, dtype=f32)
    base_decay = jnp.log(-jnp.log1p(-(2.0 ** (-5.0 - heads))))
    return {
        'x': nrm(ks[0], (BATCH, SEQ, D_MODEL), 1.0),
        'c': nrm(ks[1], (BATCH, D_MODEL), 1.0),
        'ctx': nrm(ks[2], (BATCH, CTX_LEN, D_MODEL), 1.0),
        'c_ctx': nrm(ks[3], (D_MODEL,), 1.0),
        'norm_g': 1.0 + nrm(ks[4], (DEPTH, D_MODEL), 0.02),
        'w_mod': nrm(ks[5], (DEPTH, D_MODEL, 3 * D_MODEL), D_MODEL ** -0.5),
        'b_mod': nrm(ks[6], (DEPTH, 3 * D_MODEL), 0.02),
        'ev_w_in': nrm(ks[7], (N_EVEN, D_MODEL, EV_IN), D_MODEL ** -0.5),
        'ev_w_out': nrm(ks[8], (N_EVEN, EV_MIX, D_MODEL), EV_MIX ** -0.5),
        'diff_lambda': nrm(ks[9], (N_EVEN, 4, A_HEAD_DIM), 0.1),
        'diff_subln': 1.0 + nrm(ks[10], (N_EVEN, A_V_DIM), 0.02),
        'ret_decay': base_decay + nrm(ks[11], (N_EVEN, 2, B_HEADS), 0.05),
        'ret_gn': 1.0 + nrm(ks[12], (N_EVEN, B_HEADS, B_V_DIM), 0.02),
        'od_w_in': nrm(ks[13], (N_ODD, D_MODEL, OD_IN), D_MODEL ** -0.5),
        'od_w_out': nrm(ks[14], (N_ODD, C_WIDTH, D_MODEL), C_WIDTH ** -0.5),
        'qk_norm': 1.0 + nrm(ks[15], (N_ODD, 2, C_HEAD_DIM), 0.02),
        'final_norm': 1.0 + nrm(ks[16], (D_MODEL,), 0.02),
    }


def reference(x, c, ctx, c_ctx, norm_g, w_mod, b_mod, ev_w_in, ev_w_out, diff_lambda, diff_subln,
              ret_decay, ret_gn, od_w_in, od_w_out, qk_norm, final_norm):
    n_lat = x.shape[1]
    rows, cols = grid_positions(n_lat)
    rope_a = rope_tables(rows, cols, A_HEAD_DIM)
    rope_c = rope_tables(rows, cols, C_HEAD_DIM)
    s_lat = jax.nn.silu(c)
    s_ctx = jax.nn.silu(c_ctx)
    for i in range(DEPTH):
        shift, scale, gate = jnp.split(s_lat @ w_mod[i] + b_mod[i], 3, axis=-1)
        shift_c, scale_c, gate_c = jnp.split(s_ctx @ w_mod[i] + b_mod[i], 3, axis=-1)
        h_lat = rms_norm(x, norm_g[i]) * (1 + scale[:, None]) + shift[:, None]
        h_ctx = rms_norm(ctx, norm_g[i]) * (1 + scale_c) + shift_c
        need_ctx = i < DEPTH - 1
        if i % 2 == 0:
            e = i // 2
            y_lat, y_ctx = even_mixer(h_lat, h_ctx, ev_w_in[e], ev_w_out[e], diff_lambda[e], diff_subln[e],
                                      ret_decay[e], ret_gn[e], rope_a, i, need_ctx)
        else:
            o = i // 2
            y_lat, y_ctx = odd_mixer(h_lat, h_ctx, od_w_in[o], od_w_out[o], qk_norm[o], rope_c, need_ctx)
        x = x + gate[:, None] * y_lat
        if need_ctx:
            ctx = ctx + gate_c * y_ctx
    return rms_norm(x, final_norm)
```

```cpp
#include <hip/hip_runtime.h>
#include <hip/hip_cooperative_groups.h>
#include <cstdio>
namespace cg = cooperative_groups;

typedef unsigned short bfraw;
typedef __attribute__((ext_vector_type(8))) __bf16 bf16x8;
typedef __attribute__((ext_vector_type(2))) __bf16 bf16x2;
typedef __attribute__((ext_vector_type(2))) float f32x2;
typedef __attribute__((ext_vector_type(16))) float f32x16;
typedef __attribute__((ext_vector_type(4))) float f32x4;
typedef __attribute__((ext_vector_type(4))) unsigned u32x4;
typedef __attribute__((ext_vector_type(2))) unsigned u32x2;

#define DEV static __device__ __forceinline__

constexpr int MT = 16640;
constexpr int DM = 2048;
constexpr float LOG2E = 1.4426950408889634f;
constexpr float EPSN = 1e-6f;

constexpr size_t OFF_WT_EVIN  = 0;
constexpr size_t OFF_WT_EVOUT = OFF_WT_EVIN + (size_t)2 * 7168 * 2048 * 2;
constexpr size_t OFF_WT_ODIN  = OFF_WT_EVOUT + (size_t)2 * 2048 * 2048 * 2;
constexpr size_t OFF_WT_ODOUT = OFF_WT_ODIN + (size_t)2 * 5120 * 2048 * 2;
constexpr size_t OFF_MODPART  = OFF_WT_ODOUT + (size_t)2 * 2048 * 2048 * 2;
constexpr size_t OFF_MODV     = OFF_MODPART + (size_t)16 * 4 * 2 * 6144 * 4;
constexpr size_t OFF_ROPE     = OFF_MODV + (size_t)4 * 2 * 6144 * 4;
constexpr size_t OFF_CTR      = OFF_ROPE + (size_t)(8192 + 16384) * 4;
constexpr size_t OFF_CTXRES   = OFF_CTR + 256;
constexpr size_t OFF_H        = OFF_CTXRES + (size_t)256 * 2048 * 4;
constexpr size_t OFF_PROJ     = OFF_H + (size_t)MT * 2048 * 2;
constexpr size_t SZ_A         = (size_t)MT * 1024 * 2;
constexpr size_t SZ_B         = (size_t)MT * 512 * 2;
constexpr size_t OFF_QA  = OFF_PROJ;
constexpr size_t OFF_KA  = OFF_QA + SZ_A;
constexpr size_t OFF_VTA = OFF_KA + SZ_A;
constexpr size_t OFF_GA  = OFF_VTA + SZ_A;
constexpr size_t OFF_QB  = OFF_GA + SZ_A;
constexpr size_t OFF_KB  = OFF_QB + SZ_B;
constexpr size_t OFF_KBT = OFF_KB + SZ_B;
constexpr size_t OFF_VTB = OFF_KBT + SZ_B;
constexpr size_t OFF_GB  = OFF_VTB + SZ_A;
constexpr size_t OFF_PROJ_END = OFF_GB + SZ_A;
constexpr size_t OFF_QC  = OFF_PROJ;
constexpr size_t OFF_KC  = OFF_QC + 2 * SZ_A;
constexpr size_t OFF_VTC = OFF_KC + SZ_B;
constexpr size_t OFF_GC  = OFF_VTC + SZ_B;
constexpr size_t OFF_OF  = OFF_PROJ_END;
constexpr size_t OFF_OB  = OFF_OF + (size_t)MT * 1024 * 4;
constexpr size_t OFF_DTMP = OFF_OB + (size_t)MT * 1024 * 4;
constexpr size_t WS_END  = OFF_DTMP + (size_t)1024 * 256 * 64 * 4;

struct Params {
  const float *x, *c, *ctx, *c_ctx, *norm_g, *w_mod, *b_mod, *ev_w_in, *ev_w_out, *diff_lambda, *diff_subln,
      *ret_decay, *ret_gn, *od_w_in, *od_w_out, *qk_norm, *final_norm;
  float* out;
  unsigned char* ws;
};

DEV f32x16 mfma(bf16x8 a, bf16x8 b, f32x16 c) { return __builtin_amdgcn_mfma_f32_32x32x16_bf16(a, b, c, 0, 0, 0); }
DEV unsigned pk2(float a, float b) {
  f32x2 v = {a, b};
  bf16x2 r = __builtin_convertvector(v, bf16x2);
  return __builtin_bit_cast(unsigned, r);
}
DEV u32x4 ldg(const bfraw* ubase, unsigned voff) { return *(const u32x4*)((const char*)ubase + voff); }
DEV float bflo(unsigned u) { return __uint_as_float(u << 16); }
DEV float bfhi(unsigned u) { return __uint_as_float(u & 0xffff0000u); }
DEV bf16x8 pack8(float a0, float a1, float a2, float a3, float a4, float a5, float a6, float a7) {
  u32x4 u = {pk2(a0, a1), pk2(a2, a3), pk2(a4, a5), pk2(a6, a7)};
  return __builtin_bit_cast(bf16x8, u);
}
DEV bfraw f2bf(float a) { return (bfraw)(pk2(a, 0.f) & 0xffffu); }
DEV float fexp2(float x) { return __builtin_amdgcn_exp2f(x); }
DEV float wave_sum(float v) {
#pragma unroll
  for (int o = 1; o < 64; o <<= 1) v += __shfl_xor(v, o);
  return v;
}
DEV float siluf(float v) { return v / (1.f + __expf(-v)); }
DEV int perm16(int m) {
  int b = (m >> 2) & 3;
  int b2 = ((b & 1) << 1) | (b >> 1);
  return (m & ~12) | (b2 << 2);
}

DEV const float* res_src(const Params& P, int layer, int row) {
  if (row < 256) return (layer == 0 ? P.ctx : (const float*)(P.ws + OFF_CTXRES)) + (size_t)row * DM;
  return (layer == 0 ? P.x : (const float*)P.out) + (size_t)(row - 256) * DM;
}
DEV float* res_dst(const Params& P, int row) {
  if (row < 256) return (float*)(P.ws + OFF_CTXRES) + (size_t)row * DM;
  return P.out + (size_t)(row - 256) * DM;
}

DEV void phase0(const Params& P, unsigned char* smem) {
  const int tid = threadIdx.x;
  const int gtid = blockIdx.x * 256 + tid, gsz = gridDim.x * 256;
  if (gtid < 16) ((int*)(P.ws + OFF_CTR))[gtid] = 0;
  float* rope = (float*)(P.ws + OFF_ROPE);
  for (int i = gtid; i < 4096 + 8192; i += gsz) {
    int pos, f; float inv; float *pc, *ps;
    if (i < 4096) { pos = i >> 4; f = i & 15; inv = exp2f(-(float)f * (13.287712379549449f / 16.f)); pc = rope + i; ps = rope + 4096 + i; }
    else { int j = i - 4096; pos = j >> 5; f = j & 31; inv = exp2f(-(float)f * (13.287712379549449f / 32.f)); pc = rope + 8192 + j; ps = rope + 16384 + j; }
    float ang = (float)pos * inv;
    double a = (double)ang;
    double kk = rint(a * 0.15915494309189535);
    float r = (float)(a - kk * 6.283185307179586);
    *pc = __cosf(r); *ps = __sinf(r);
  }
  const int NG = 4 * 16 * 6, NTT = 16384;
  for (int it = blockIdx.x; it < NG + NTT; it += gridDim.x) {
    if (it < NG) {
      const int layer = it / 96, rem = it % 96, kc = rem / 6, ng = rem % 6;
      const int n = ng * 1024 + tid * 4;
      const float* W = P.w_mod + ((size_t)layer * 2048 + kc * 128) * 6144 + n;
      f32x4 al = {0.f, 0.f, 0.f, 0.f}, ac = {0.f, 0.f, 0.f, 0.f};
#pragma unroll 8
      for (int k = 0; k < 128; ++k) {
        const float cl = P.c[kc * 128 + k], cc = P.c_ctx[kc * 128 + k];
        const float sl = siluf(cl), sx = siluf(cc);
        const f32x4 w4 = *(const f32x4*)(W + (size_t)k * 6144);
        al.x += sl * w4.x; al.y += sl * w4.y; al.z += sl * w4.z; al.w += sl * w4.w;
        ac.x += sx * w4.x; ac.y += sx * w4.y; ac.z += sx * w4.z; ac.w += sx * w4.w;
      }
      float* part = (float*)(P.ws + OFF_MODPART) + ((size_t)(kc * 4 + layer) * 2) * 6144;
      *(f32x4*)(part + n) = al;
      *(f32x4*)(part + 6144 + n) = ac;
    } else {
      int t = it - NG;
      const float* src; bfraw* dst; int N;
      if (t < 7168) { int l = t / 3584; t -= l * 3584; N = 7168; src = P.ev_w_in + (size_t)l * 2048 * 7168; dst = (bfraw*)(P.ws + OFF_WT_EVIN) + (size_t)l * 7168 * 2048; }
      else if (t < 7168 + 2048) { t -= 7168; int l = t / 1024; t -= l * 1024; N = 2048; src = P.ev_w_out + (size_t)l * 2048 * 2048; dst = (bfraw*)(P.ws + OFF_WT_EVOUT) + (size_t)l * 2048 * 2048; }
      else if (t < 7168 + 2048 + 5120) { t -= 9216; int l = t / 2560; t -= l * 2560; N = 5120; src = P.od_w_in + (size_t)l * 2048 * 5120; dst = (bfraw*)(P.ws + OFF_WT_ODIN) + (size_t)l * 5120 * 2048; }
      else { t -= 14336; int l = t / 1024; t -= l * 1024; N = 2048; src = P.od_w_out + (size_t)l * 2048 * 2048; dst = (bfraw*)(P.ws + OFF_WT_ODOUT) + (size_t)l * 2048 * 2048; }
      const int ntn = N >> 6;
      const int ntile = t % ntn, ktile = t / ntn;
      float* sT = (float*)smem;
#pragma unroll
      for (int j = 0; j < 4; ++j) {
        const int idx = tid + 256 * j, krow = idx >> 4, c4 = idx & 15;
        const f32x4 v = *(const f32x4*)(src + (size_t)(ktile * 64 + krow) * N + ntile * 64 + c4 * 4);
        float* d = sT + krow * 65 + c4 * 4;
        d[0] = v.x; d[1] = v.y; d[2] = v.z; d[3] = v.w;
      }
      __syncthreads();
#pragma unroll
      for (int j = 0; j < 2; ++j) {
        const int idx = tid + 256 * j, kg = idx & 7, n = idx >> 3;
        const float* s = sT + (kg * 8) * 65 + n;
        u32x4 u = {pk2(s[0], s[65]), pk2(s[130], s[195]), pk2(s[260], s[325]), pk2(s[390], s[455])};
        *(u32x4*)(dst + (size_t)(ntile * 64 + n) * 2048 + ktile * 64 + kg * 8) = u;
      }
      __syncthreads();
    }
  }
}

DEV void phase0b(const Params& P) {
  const int gtid = blockIdx.x * 256 + threadIdx.x, gsz = gridDim.x * 256;
  const float* part = (const float*)(P.ws + OFF_MODPART);
  float* modv = (float*)(P.ws + OFF_MODV);
  for (int i = gtid; i < 4 * 2 * 6144; i += gsz) {
    const int layer = i / 12288, rem = i % 12288, which = rem / 6144, n = rem % 6144;
    float s = P.b_mod[layer * 6144 + n];
#pragma unroll
    for (int kc = 0; kc < 16; ++kc) s += part[((size_t)(kc * 4 + layer) * 2 + which) * 6144 + n];
    modv[i] = s;
  }
}

DEV void phase_norm(const Params& P, int layer) {
  const int lane = threadIdx.x & 63, w = threadIdx.x >> 6;
  const float* g = P.norm_g + layer * 2048;
  const float* modv = (const float*)(P.ws + OFF_MODV) + (size_t)layer * 2 * 6144;
  bfraw* H = (bfraw*)(P.ws + OFF_H);
  for (int row = blockIdx.x * 4 + w; row < MT; row += gridDim.x * 4) {
    const float* src = res_src(P, layer, row);
    const float* mv = modv + (row < 256 ? 6144 : 0);
    f32x4 v[8];
    float ss = 0.f;
#pragma unroll
    for (int it = 0; it < 8; ++it) {
      v[it] = *(const f32x4*)(src + (it * 64 + lane) * 4);
      ss += v[it].x * v[it].x + v[it].y * v[it].y + v[it].z * v[it].z + v[it].w * v[it].w;
    }
    ss = wave_sum(ss);
    const float rstd = rsqrtf(ss * (1.f / 2048.f) + EPSN);
#pragma unroll
    for (int it = 0; it < 8; ++it) {
      const int c = (it * 64 + lane) * 4;
      const f32x4 g4 = *(const f32x4*)(g + c);
      const f32x4 sh = *(const f32x4*)(mv + c);
      const f32x4 sc = *(const f32x4*)(mv + 2048 + c);
      const float y0 = v[it].x * rstd * g4.x * (1.f + sc.x) + sh.x;
      const float y1 = v[it].y * rstd * g4.y * (1.f + sc.y) + sh.y;
      const float y2 = v[it].z * rstd * g4.z * (1.f + sc.z) + sh.z;
      const float y3 = v[it].w * rstd * g4.w * (1.f + sc.w) + sh.w;
      u32x2 u = {pk2(y0, y1), pk2(y2, y3)};
      *(u32x2*)(H + (size_t)row * 2048 + c) = u;
    }
  }
}

DEV void phase_final(const Params& P) {
  const int lane = threadIdx.x & 63, w = threadIdx.x >> 6;
  for (int row = blockIdx.x * 4 + w; row < 16384; row += gridDim.x * 4) {
    float* src = P.out + (size_t)row * DM;
    f32x4 v[8];
    float ss = 0.f;
#pragma unroll
    for (int it = 0; it < 8; ++it) {
      v[it] = *(const f32x4*)(src + (it * 64 + lane) * 4);
      ss += v[it].x * v[it].x + v[it].y * v[it].y + v[it].z * v[it].z + v[it].w * v[it].w;
    }
    ss = wave_sum(ss);
    const float rstd = rsqrtf(ss * (1.f / 2048.f) + EPSN);
#pragma unroll
    for (int it = 0; it < 8; ++it) {
      const int c = (it * 64 + lane) * 4;
      const f32x4 g4 = *(const f32x4*)(P.final_norm + c);
      f32x4 y = {v[it].x * rstd * g4.x, v[it].y * rstd * g4.y, v[it].z * rstd * g4.z, v[it].w * rstd * g4.w};
      *(f32x4*)(src + c) = y;
    }
  }
}

template <bool FEAT>
DEV void gemm_main(const bfraw* A, const bfraw* W, int m0, int n0, bfraw* lds, f32x16 (&acc)[4]) {
  const int tid = threadIdx.x, lane = tid & 63, w = tid >> 6, l31 = lane & 31, hh = lane >> 5;
  const int srow = tid >> 3, scol = (tid & 7) * 8;
  const bfraw* ap = A + (size_t)m0 * 2048;
  const bfraw* wp = W + (size_t)n0 * 2048;
  const unsigned goff = (unsigned)(srow * 2048 + scol) * 2u;
  u32x4 ra[4], rw[4];
#pragma unroll
  for (int j = 0; j < 4; ++j) {
    ra[j] = ldg(ap + (size_t)j * 32 * 2048, goff);
    rw[j] = ldg(wp + (size_t)j * 32 * 2048, goff);
  }
#pragma unroll
  for (int nt = 0; nt < 4; ++nt)
#pragma unroll
    for (int r = 0; r < 16; ++r) acc[nt][r] = 0.f;
#pragma unroll
  for (int j = 0; j < 4; ++j) {
    *(u32x4*)(lds + (srow + 32 * j) * 72 + scol) = ra[j];
    *(u32x4*)(lds + 9216 + (srow + 32 * j) * 72 + scol) = rw[j];
  }
  __syncthreads();
#pragma unroll 1
  for (int kt = 0; kt < 32; ++kt) {
    const bfraw* cA = lds + (kt & 1) * 18432;
    const bfraw* cB = cA + 9216;
    if (kt + 1 < 32) {
#pragma unroll
      for (int j = 0; j < 4; ++j) {
        ra[j] = ldg(ap + (size_t)j * 32 * 2048 + (kt + 1) * 64, goff);
        rw[j] = ldg(wp + (size_t)j * 32 * 2048 + (kt + 1) * 64, goff);
      }
    }
#pragma unroll
    for (int s = 0; s < 4; ++s) {
      const bf16x8 fm = *(const bf16x8*)(cA + (32 * w + l31) * 72 + s * 16 + hh * 8);
#pragma unroll
      for (int nt = 0; nt < 4; ++nt) {
        const bf16x8 fn = *(const bf16x8*)(cB + (32 * nt + l31) * 72 + s * 16 + hh * 8);
        if (FEAT) acc[nt] = mfma(fm, fn, acc[nt]);
        else acc[nt] = mfma(fn, fm, acc[nt]);
      }
    }
    if (kt + 1 < 32) {
      bfraw* nA = lds + ((kt + 1) & 1) * 18432;
#pragma unroll
      for (int j = 0; j < 4; ++j) {
        *(u32x4*)(nA + (srow + 32 * j) * 72 + scol) = ra[j];
        *(u32x4*)(nA + 9216 + (srow + 32 * j) * 72 + scol) = rw[j];
      }
    }
    __syncthreads();
  }
}

DEV void phase_gemm(const Params& P, int layer, int kind, unsigned char* smem) {
  const int tid = threadIdx.x, lane = tid & 63, w = tid >> 6, l31 = lane & 31, hh = lane >> 5;
  bfraw* lds = (bfraw*)smem;
  const int eo = layer >> 1;
  const bfraw* A = (const bfraw*)(P.ws + OFF_H);
  const bfraw* W;
  int NTN, mt0 = 0;
  if (kind == 0) { W = (const bfraw*)(P.ws + OFF_WT_EVIN) + (size_t)eo * 7168 * 2048; NTN = 56; }
  else if (kind == 1) { W = (const bfraw*)(P.ws + OFF_WT_ODIN) + (size_t)eo * 5120 * 2048; NTN = 40; }
  else { W = (const bfraw*)(P.ws + ((layer & 1) ? OFF_WT_ODOUT : OFF_WT_EVOUT)) + (size_t)eo * 2048 * 2048; NTN = 16; if (layer == 3) mt0 = 2; }
  const float* rope = (const float*)(P.ws + OFF_ROPE);
  const int ntiles = (130 - mt0) * NTN;
  for (int t = blockIdx.x; t < ntiles; t += gridDim.x) {
    const int mt = mt0 + t / NTN, tn = t % NTN;
    const int m0 = mt * 128, n0 = tn * 128;
    f32x16 acc[4];
    int vcol = -1; bfraw* vdst = nullptr;
    if (kind == 0) {
      if (tn >= 16 && tn < 24) { vcol = (tn - 16) * 128; vdst = (bfraw*)(P.ws + OFF_VTA); }
      else if (tn >= 40 && tn < 48) { vcol = (tn - 40) * 128; vdst = (bfraw*)(P.ws + OFF_VTB); }
    } else if (kind == 1) {
      if (tn >= 20 && tn < 24) { vcol = (tn - 20) * 128; vdst = (bfraw*)(P.ws + OFF_VTC); }
    }
    if (vcol >= 0) {
      gemm_main<true>(A, W, m0, n0, lds, acc);
#pragma unroll
      for (int nt = 0; nt < 4; ++nt) {
        bfraw* rowp = vdst + (size_t)(vcol + 32 * nt + l31) * MT;
#pragma unroll
        for (int g = 0; g < 4; ++g) {
          const int pos = m0 + 32 * w + 16 * (g >> 1) + 8 * hh + 4 * (g & 1);
          u32x2 u = {pk2(acc[nt][4 * g], acc[nt][4 * g + 1]), pk2(acc[nt][4 * g + 2], acc[nt][4 * g + 3])};
          *(u32x2*)(rowp + pos) = u; __builtin_amdgcn_sched_barrier(0);
        }
      }
      continue;
    }
    gemm_main<false>(A, W, m0, n0, lds, acc);
    const int m = m0 + 32 * w + l31;
    const bool lat = m0 >= 256;
    const int tl = m - 256;
    const int prow = (tl >> 6) & 255, pcol = tl & 63;
    if (kind == 2) {
      const float* gate = (const float*)(P.ws + OFF_MODV) + ((size_t)layer * 2 + (lat ? 0 : 1)) * 6144 + 4096;
      const float* srow_ = res_src(P, layer, m);
      float* drow = res_dst(P, m);
#pragma unroll
      for (int nt = 0; nt < 4; ++nt)
#pragma unroll
        for (int g = 0; g < 4; ++g) {
          const int n = n0 + 32 * nt + 8 * g + 4 * hh;
          f32x4 xo = *(const f32x4*)(srow_ + n);
          const f32x4 gt = *(const f32x4*)(gate + n);
          xo.x += gt.x * acc[nt][4 * g]; xo.y += gt.y * acc[nt][4 * g + 1];
          xo.z += gt.z * acc[nt][4 * g + 2]; xo.w += gt.w * acc[nt][4 * g + 3];
          *(f32x4*)(drow + n) = xo; __builtin_amdgcn_sched_barrier(0);
        }
      continue;
    }
    if (kind == 0) {
      if (tn < 16) {
        const bool isq = tn < 8;
        const int hb = 2 * (isq ? tn : tn - 8);
        bfraw* dst = (bfraw*)(P.ws + (isq ? OFF_QA : OFF_KA));
        const float scl = isq ? 0.125f * LOG2E : 1.f;
        if (lat) {
#pragma unroll
          for (int nt = 0; nt < 4; ++nt) {
            const int pos = (nt & 1) ? pcol : prow;
#pragma unroll
            for (int g = 0; g < 2; ++g) {
              const f32x4 c4 = *(const f32x4*)(rope + pos * 16 + 8 * g + 4 * hh);
              const f32x4 s4 = *(const f32x4*)(rope + 4096 + pos * 16 + 8 * g + 4 * hh);
              const float cc[4] = {c4.x, c4.y, c4.z, c4.w}, sn[4] = {s4.x, s4.y, s4.z, s4.w};
#pragma unroll
              for (int j = 0; j < 4; ++j) {
                const float x1 = acc[nt][4 * g + j], x2 = acc[nt][4 * g + j + 8];
                acc[nt][4 * g + j] = x1 * cc[j] - x2 * sn[j];
                acc[nt][4 * g + j + 8] = x1 * sn[j] + x2 * cc[j];
              }
              __builtin_amdgcn_sched_barrier(0);
            }
          }
        }
#pragma unroll
        for (int nt = 0; nt < 4; ++nt) {
          bfraw* rp = dst + ((size_t)(hb + (nt >> 1)) * MT + m) * 64 + (nt & 1) * 32 + 4 * hh;
#pragma unroll
          for (int g = 0; g < 4; ++g) {
            u32x2 u = {pk2(acc[nt][4 * g] * scl, acc[nt][4 * g + 1] * scl), pk2(acc[nt][4 * g + 2] * scl, acc[nt][4 * g + 3] * scl)};
            *(u32x2*)(rp + 8 * g) = u; __builtin_amdgcn_sched_barrier(0);
          }
        }
      } else if (tn < 32 || tn >= 48) {
        bfraw* dst = (tn < 32) ? (bfraw*)(P.ws + OFF_GA) + (size_t)m * 1024 + (tn - 24) * 128
                               : (bfraw*)(P.ws + OFF_GB) + (size_t)m * 1024 + (tn - 48) * 128;
#pragma unroll
        for (int nt = 0; nt < 4; ++nt)
#pragma unroll
          for (int g = 0; g < 4; ++g) {
            u32x2 u = {pk2(siluf(acc[nt][4 * g]), siluf(acc[nt][4 * g + 1])), pk2(siluf(acc[nt][4 * g + 2]), siluf(acc[nt][4 * g + 3]))};
            *(u32x2*)(dst + 32 * nt + 8 * g + 4 * hh) = u; __builtin_amdgcn_sched_barrier(0);
          }
      } else if (tn < 36) {
        bfraw* rp = (bfraw*)(P.ws + OFF_QB) + ((size_t)(tn - 32) * MT + m) * 128 + 4 * hh;
#pragma unroll
        for (int nt = 0; nt < 4; ++nt)
#pragma unroll
          for (int g = 0; g < 4; ++g) {
            u32x2 u = {pk2(acc[nt][4 * g], acc[nt][4 * g + 1]), pk2(acc[nt][4 * g + 2], acc[nt][4 * g + 3])};
            *(u32x2*)(rp + 32 * nt + 8 * g) = u; __builtin_amdgcn_sched_barrier(0);
          }
      } else {
        const int head = tn - 36;
        const float scl = 0.08838834764831845f;
        bfraw* rp = (bfraw*)(P.ws + OFF_KB) + ((size_t)head * MT + m) * 128 + 4 * hh;
        bfraw* tp = (bfraw*)(P.ws + OFF_KBT) + (size_t)(head * 128) * MT + perm16(m);
#pragma unroll
        for (int nt = 0; nt < 4; ++nt)
#pragma unroll
          for (int g = 0; g < 4; ++g) {
            const unsigned u0 = pk2(acc[nt][4 * g] * scl, acc[nt][4 * g + 1] * scl);
            const unsigned u1 = pk2(acc[nt][4 * g + 2] * scl, acc[nt][4 * g + 3] * scl);
            u32x2 u = {u0, u1};
            *(u32x2*)(rp + 32 * nt + 8 * g) = u; __builtin_amdgcn_sched_barrier(0);
            const int nl = 32 * nt + 8 * g + 4 * hh;
            tp[(size_t)(nl + 0) * MT] = (bfraw)(u0 & 0xffffu);
            tp[(size_t)(nl + 1) * MT] = (bfraw)(u0 >> 16);
            tp[(size_t)(nl + 2) * MT] = (bfraw)(u1 & 0xffffu);
            tp[(size_t)(nl + 3) * MT] = (bfraw)(u1 >> 16); __builtin_amdgcn_sched_barrier(0);
          }
      }
    } else {
      if (tn < 20) {
        const bool isq = tn < 16;
        const int head = isq ? tn : tn - 16;
        const float* qg = P.qk_norm + eo * 256 + (isq ? 0 : 128);
        bfraw* rp = (bfraw*)(P.ws + (isq ? OFF_QC : OFF_KC)) + ((size_t)head * MT + m) * 128 + 4 * hh;
        const float scl = isq ? 0.08838834764831845f * LOG2E : 1.f;
        float ss = 0.f;
#pragma unroll
        for (int nt = 0; nt < 4; ++nt)
#pragma unroll
          for (int r = 0; r < 16; ++r) ss += acc[nt][r] * acc[nt][r];
        ss += __shfl_xor(ss, 32);
        const float rstd = rsqrtf(ss * (1.f / 128.f) + EPSN);
#pragma unroll
        for (int nt = 0; nt < 4; ++nt)
#pragma unroll
          for (int g = 0; g < 4; ++g) {
            const f32x4 g4 = *(const f32x4*)(qg + 32 * nt + 8 * g + 4 * hh);
            acc[nt][4 * g] *= rstd * g4.x; acc[nt][4 * g + 1] *= rstd * g4.y;
            acc[nt][4 * g + 2] *= rstd * g4.z; acc[nt][4 * g + 3] *= rstd * g4.w; __builtin_amdgcn_sched_barrier(0);
          }
        if (lat) {
#pragma unroll
          for (int p = 0; p < 2; ++p) {
            const int pos = p ? pcol : prow;
#pragma unroll
            for (int g = 0; g < 4; ++g) {
              const f32x4 c4 = *(const f32x4*)(rope + 8192 + pos * 32 + 8 * g + 4 * hh);
              const f32x4 s4 = *(const f32x4*)(rope + 16384 + pos * 32 + 8 * g + 4 * hh);
              const float cc[4] = {c4.x, c4.y, c4.z, c4.w}, sn[4] = {s4.x, s4.y, s4.z, s4.w};
#pragma unroll
              for (int j = 0; j < 4; ++j) {
                const float x1 = acc[2 * p][4 * g + j], x2 = acc[2 * p + 1][4 * g + j];
                acc[2 * p][4 * g + j] = x1 * cc[j] - x2 * sn[j];
                acc[2 * p + 1][4 * g + j] = x1 * sn[j] + x2 * cc[j];
              }
              __builtin_amdgcn_sched_barrier(0);
            }
          }
        }
#pragma unroll
        for (int nt = 0; nt < 4; ++nt)
#pragma unroll
          for (int g = 0; g < 4; ++g) {
            u32x2 u = {pk2(acc[nt][4 * g] * scl, acc[nt][4 * g + 1] * scl), pk2(acc[nt][4 * g + 2] * scl, acc[nt][4 * g + 3] * scl)};
            *(u32x2*)(rp + 32 * nt + 8 * g) = u; __builtin_amdgcn_sched_barrier(0);
          }
      } else {
        bfraw* dst = (bfraw*)(P.ws + OFF_GC) + (size_t)m * 2048 + (tn - 24) * 128;
#pragma unroll
        for (int nt = 0; nt < 4; ++nt)
#pragma unroll
          for (int g = 0; g < 4; ++g) {
            u32x2 u = {pk2(siluf(acc[nt][4 * g]), siluf(acc[nt][4 * g + 1])), pk2(siluf(acc[nt][4 * g + 2]), siluf(acc[nt][4 * g + 3]))};
            *(u32x2*)(dst + 32 * nt + 8 * g + 4 * hh) = u; __builtin_amdgcn_sched_barrier(0);
          }
      }
    }
  }
}

template <int D>
DEV void flash_block(const bfraw* Qh, const bfraw* Kh, const bfraw* Vt, int q0, int nk, bfraw* lds, f32x16 (&O)[4], float& lsum) {
  constexpr int KS = D + 8;
  constexpr int KT = 64 * KS;
  constexpr int STG = KT + 128 * 72;
  constexpr int KCH = D / 8;
  constexpr int NKC = 64 * KCH / 256;
  const int tid = threadIdx.x, lane = tid & 63, w = tid >> 6, l31 = lane & 31, hh = lane >> 5;
  bf16x8 qf[D / 16];
  {
    const bfraw* qp = Qh + (size_t)(q0 + 32 * w + l31) * D + 8 * hh;
#pragma unroll
    for (int s = 0; s < D / 16; ++s) qf[s] = *(const bf16x8*)(qp + 16 * s);
  }
#pragma unroll
  for (int d = 0; d < 4; ++d)
#pragma unroll
    for (int r = 0; r < 16; ++r) O[d][r] = 0.f;
  lsum = 0.f;
  float mrun = -INFINITY;
  u32x4 rk[NKC], rv[4];
  const int krow = tid / KCH, kcol = (tid % KCH) * 8;
  const int vrow = tid >> 3, vcol = (tid & 7) * 8;
  const unsigned koff = (unsigned)(krow * D + kcol) * 2u, voff = (unsigned)(vrow * MT + vcol) * 2u;
#pragma unroll
  for (int j = 0; j < NKC; ++j) rk[j] = ldg(Kh + (size_t)j * (256 / KCH) * D, koff);
#pragma unroll
  for (int j = 0; j < 4; ++j) rv[j] = ldg(Vt + (size_t)j * 32 * MT, voff);
#pragma unroll
  for (int j = 0; j < NKC; ++j) *(u32x4*)(lds + (krow + j * (256 / KCH)) * KS + kcol) = rk[j];
#pragma unroll
  for (int j = 0; j < 4; ++j) *(u32x4*)(lds + KT + (vrow + 32 * j) * 72 + vcol) = rv[j];
  __syncthreads();
  const int ntile = nk >> 6;
#pragma unroll 1
  for (int t = 0; t < ntile; ++t) {
    const bfraw* sK = lds + (t & 1) * STG;
    const bfraw* sV = sK + KT;
    if (t + 1 < ntile) {
      const int key0 = (t + 1) * 64;
#pragma unroll
      for (int j = 0; j < NKC; ++j) rk[j] = ldg(Kh + (size_t)(key0 + j * (256 / KCH)) * D, koff);
#pragma unroll
      for (int j = 0; j < 4; ++j) rv[j] = ldg(Vt + (size_t)j * 32 * MT + key0, voff);
    }
    f32x16 sc[2];
#pragma unroll
    for (int kt = 0; kt < 2; ++kt) {
#pragma unroll
      for (int r = 0; r < 16; ++r) sc[kt][r] = 0.f;
#pragma unroll
      for (int s = 0; s < D / 16; ++s) {
        const bf16x8 kf = *(const bf16x8*)(sK + (32 * kt + l31) * KS + 16 * s + 8 * hh);
        sc[kt] = mfma(kf, qf[s], sc[kt]);
      }
    }
    float mx = sc[0][0];
#pragma unroll
    for (int r = 1; r < 16; ++r) mx = fmaxf(mx, sc[0][r]);
#pragma unroll
    for (int r = 0; r < 16; ++r) mx = fmaxf(mx, sc[1][r]);
    mx = fmaxf(mx, __shfl_xor(mx, 32));
    const float mnew = fmaxf(mrun, mx);
    const float alpha = fexp2(mrun - mnew);
    mrun = mnew;
    float ps = 0.f;
#pragma unroll
    for (int kt = 0; kt < 2; ++kt)
#pragma unroll
      for (int r = 0; r < 16; ++r) {
        const float p = fexp2(sc[kt][r] - mnew);
        sc[kt][r] = p;
        ps += p;
      }
    lsum = lsum * alpha + ps;
#pragma unroll
    for (int d = 0; d < 4; ++d)
#pragma unroll
      for (int r = 0; r < 16; ++r) O[d][r] *= alpha;
#pragma unroll
    for (int kt = 0; kt < 2; ++kt)
#pragma unroll
      for (int tt = 0; tt < 2; ++tt) {
        const bf16x8 pf = pack8(sc[kt][8 * tt], sc[kt][8 * tt + 1], sc[kt][8 * tt + 2], sc[kt][8 * tt + 3],
                                sc[kt][8 * tt + 4], sc[kt][8 * tt + 5], sc[kt][8 * tt + 6], sc[kt][8 * tt + 7]);
#pragma unroll
        for (int d = 0; d < 4; ++d) {
          const bf16x8 vf = *(const bf16x8*)(sV + (32 * d + l31) * 72 + 32 * kt + 16 * tt + 8 * hh);
          O[d] = mfma(vf, pf, O[d]);
        }
      }
    if (t + 1 < ntile) {
      bfraw* nK = lds + ((t + 1) & 1) * STG;
#pragma unroll
      for (int j = 0; j < NKC; ++j) *(u32x4*)(nK + (krow + j * (256 / KCH)) * KS + kcol) = rk[j];
#pragma unroll
      for (int j = 0; j < 4; ++j) *(u32x4*)(nK + KT + (vrow + 32 * j) * 72 + vcol) = rv[j];
    }
    __syncthreads();
  }
  lsum += __shfl_xor(lsum, 32);
}

DEV void chain_item(const Params& P, int e, int it, bfraw* lds) {
  const int tid = threadIdx.x, lane = tid & 63, w = tid >> 6, l31 = lane & 31, hh = lane >> 5;
  const int dir = it >> 3, head = (it >> 1) & 3, half = it & 1;
  const float lg2 = -__expf(P.ret_decay[e * 8 + dir * 4 + head]) * LOG2E;
  const float cd = exp2f(lg2 * 64.f);
  float kdec[8];
#pragma unroll
  for (int e8 = 0; e8 < 8; ++e8) {
    const int slot = (tid & 7) * 8 + e8;
    const int orig = perm16(slot);
    kdec[e8] = exp2f(lg2 * (float)(dir == 0 ? 63 - orig : orig));
  }
  bfraw* sQ = lds;
  bfraw* sK = lds + 8704;
  bfraw* sKt = lds + 17408;
  bfraw* sV = lds + 26624;
  const bfraw* Qg = (const bfraw*)(P.ws + OFF_QB) + (size_t)head * MT * 128;
  const bfraw* Kg = (const bfraw*)(P.ws + OFF_KB) + (size_t)head * MT * 128;
  const bfraw* Ktg = (const bfraw*)(P.ws + OFF_KBT) + (size_t)(head * 128) * MT;
  const bfraw* Vg = (const bfraw*)(P.ws + OFF_VTB) + (size_t)(head * 256 + half * 128) * MT;
  float* og = (float*)(P.ws + (dir ? OFF_OB : OFF_OF));
  f32x16 St[4];
#pragma unroll
  for (int d = 0; d < 4; ++d)
#pragma unroll
    for (int r = 0; r < 16; ++r) St[d][r] = 0.f;
  u32x4 rq[4], rk[4], rkt[4], rv[4];
  const int qrow = tid >> 4, qcol = (tid & 15) * 8;
  const int trow = tid >> 3, tcol = (tid & 7) * 8;
  const unsigned qoff = (unsigned)(qrow * 128 + qcol) * 2u, toff = (unsigned)(trow * MT + tcol) * 2u;
#pragma unroll 1
  for (int n = 0; n < 260; ++n) {
    const int r0 = dir == 0 ? 64 * n : (n < 4 ? 192 - 64 * n : 16576 - 64 * (n - 4));
    float lg2v = lg2;
    int lanev = lane;
    asm volatile("" : "+v"(lg2v), "+v"(lanev));
    const int l31v = lanev & 31, hhv = lanev >> 5;
    __syncthreads();
#pragma unroll
    for (int j = 0; j < 4; ++j) {
      rq[j] = ldg(Qg + (size_t)(r0 + 16 * j) * 128, qoff);
      rk[j] = ldg(Kg + (size_t)(r0 + 16 * j) * 128, qoff);
      rkt[j] = ldg(Ktg + (size_t)(32 * j) * MT + r0, toff);
      rv[j] = ldg(Vg + (size_t)(32 * j) * MT + r0, toff);
    }
#pragma unroll
    for (int j = 0; j < 4; ++j) {
      *(u32x4*)(sQ + (qrow + 16 * j) * 136 + qcol) = rq[j];
      *(u32x4*)(sK + (qrow + 16 * j) * 136 + qcol) = rk[j];
      *(u32x4*)(sV + (trow + 32 * j) * 72 + tcol) = rv[j];
      u32x4 u = rkt[j];
      u.x = pk2(bflo(u.x) * kdec[0], bfhi(u.x) * kdec[1]);
      u.y = pk2(bflo(u.y) * kdec[2], bfhi(u.y) * kdec[3]);
      u.z = pk2(bflo(u.z) * kdec[4], bfhi(u.z) * kdec[5]);
      u.w = pk2(bflo(u.w) * kdec[6], bfhi(u.w) * kdec[7]);
      *(u32x4*)(sKt + (trow + 32 * j) * 72 + tcol) = u;
    }
    __syncthreads();
#pragma unroll
    for (int qt = 0; qt < 2; ++qt) {
      f32x16 O;
#pragma unroll
      for (int r = 0; r < 16; ++r) O[r] = 0.f;
#pragma unroll
      for (int dkt = 0; dkt < 4; ++dkt)
#pragma unroll
        for (int tt = 0; tt < 2; ++tt) {
          const bf16x8 af = pack8(St[dkt][8 * tt], St[dkt][8 * tt + 1], St[dkt][8 * tt + 2], St[dkt][8 * tt + 3],
                                  St[dkt][8 * tt + 4], St[dkt][8 * tt + 5], St[dkt][8 * tt + 6], St[dkt][8 * tt + 7]);
          const bfraw* qp = sQ + (32 * qt + l31) * 136 + 32 * dkt + 16 * tt + 4 * hh;
          const u32x2 lo = *(const u32x2*)qp;
          const u32x2 hi = *(const u32x2*)(qp + 8);
          u32x4 u = {lo.x, lo.y, hi.x, hi.y};
          O = mfma(af, __builtin_bit_cast(bf16x8, u), O);
        }
      {
        const int offq = 32 * qt + l31v;
        const float qd = fexp2(lg2v * (float)(dir == 0 ? offq + 1 : 64 - offq));
#pragma unroll
        for (int r = 0; r < 16; ++r) O[r] *= qd;
      }
#pragma unroll
      for (int kt = 0; kt < 2; ++kt) {
        if (dir == 0 ? (kt <= qt) : (kt >= qt)) {
          f32x16 sc;
#pragma unroll
          for (int r = 0; r < 16; ++r) sc[r] = 0.f;
#pragma unroll
          for (int s = 0; s < 8; ++s) {
            const bf16x8 kf = *(const bf16x8*)(sK + (32 * kt + l31) * 136 + 16 * s + 8 * hh);
            const bf16x8 qf = *(const bf16x8*)(sQ + (32 * qt + l31) * 136 + 16 * s + 8 * hh);
            sc = mfma(kf, qf, sc);
          }
          const int offq = 32 * qt + l31v;
#pragma unroll
          for (int r = 0; r < 16; ++r) {
            const int offk = 32 * kt + 8 * (r >> 2) + 4 * hhv + (r & 3);
            const int dl = dir == 0 ? offq - offk : offk - offq;
            sc[r] = dl >= 0 ? sc[r] * fexp2(lg2v * (float)dl) : 0.f;
          }
#pragma unroll
          for (int tt = 0; tt < 2; ++tt) {
            const bf16x8 pf = pack8(sc[8 * tt], sc[8 * tt + 1], sc[8 * tt + 2], sc[8 * tt + 3],
                                    sc[8 * tt + 4], sc[8 * tt + 5], sc[8 * tt + 6], sc[8 * tt + 7]);
            const bf16x8 vf = *(const bf16x8*)(sV + (32 * w + l31) * 72 + 32 * kt + 16 * tt + 8 * hh);
            O = mfma(vf, pf, O);
          }
        }
      }
      float* op = og + (size_t)(r0 + 32 * qt + l31) * 1024 + head * 256 + half * 128 + 32 * w + 4 * hh;
#pragma unroll
      for (int g = 0; g < 4; ++g) {
        f32x4 v = {O[4 * g], O[4 * g + 1], O[4 * g + 2], O[4 * g + 3]};
        *(f32x4*)(op + 8 * g) = v;
      }
    }
#pragma unroll
    for (int d = 0; d < 4; ++d)
#pragma unroll
      for (int r = 0; r < 16; ++r) St[d][r] *= cd;
#pragma unroll
    for (int tt = 0; tt < 4; ++tt) {
      const bf16x8 vf = *(const bf16x8*)(sV + (32 * w + l31) * 72 + 16 * tt + 8 * hh);
#pragma unroll
      for (int dkt = 0; dkt < 4; ++dkt) {
        const bf16x8 kf = *(const bf16x8*)(sKt + (32 * dkt + l31) * 72 + 16 * tt + 8 * hh);
        St[dkt] = mfma(kf, vf, St[dkt]);
      }
    }
  }
  __syncthreads();
}

DEV int next_item(int* ctr, int* s_item) {
  __syncthreads();
  if (threadIdx.x == 0) *s_item = atomicAdd(ctr, 1);
  __syncthreads();
  return *s_item;
}

DEV void phase_attn_even(const Params& P, int layer, unsigned char* smem, int* s_item) {
  const int tid = threadIdx.x, lane = tid & 63, w = tid >> 6, l31 = lane & 31, hh = lane >> 5;
  bfraw* lds = (bfraw*)smem;
  const int e = layer >> 1;
  const float lambda_init = 0.8f - 0.6f * expf(-0.3f * (float)layer);
  float s01 = 0.f, s23 = 0.f;
  {
    const float* lp = P.diff_lambda + e * 256;
    for (int i = 0; i < 64; ++i) { s01 += lp[i] * lp[64 + i]; s23 += lp[128 + i] * lp[192 + i]; }
  }
  const float lam = expf(s01) - expf(s23) + lambda_init;
  int* ctr = (int*)(P.ws + OFF_CTR) + layer;
  const int NCH = 16, NLAT = 8 * 128, NCX = 8 * 2;
  const int total = NCH + NLAT + NCX;
  int itq = next_item(ctr, s_item);
#ifndef NO_CHAIN
  while (itq < NCH) { chain_item(P, e, itq, lds); itq = next_item(ctr, s_item); }
#endif
  for (;; itq = next_item(ctr, s_item)) {
    if (itq >= total) break;
    int it = itq - NCH;
    int hd, q0, nk;
    if (it < NLAT) { hd = it >> 7; q0 = 256 + 128 * (it & 127); nk = MT; }
    else { it -= NLAT; hd = it >> 1; q0 = 128 * (it & 1); nk = 256; }
    f32x16 O[4];
    float l;
    float* tmp = (float*)(P.ws + OFF_DTMP) + ((size_t)blockIdx.x * 16 * 256 + tid) * 4;
    const bfraw* Vt = (const bfraw*)(P.ws + OFF_VTA) + (size_t)(hd * 128) * MT;
#pragma unroll 1
    for (int a = 0; a < 2; ++a) {
      const bfraw* Qh = (const bfraw*)(P.ws + OFF_QA) + (size_t)(2 * hd + a) * MT * 64;
      const bfraw* Kh = (const bfraw*)(P.ws + OFF_KA) + (size_t)(2 * hd + a) * MT * 64;
      flash_block<64>(Qh, Kh, Vt, q0, nk, lds, O, l);
      if (a == 0) {
        const float inv = 1.f / l;
#pragma unroll
        for (int d = 0; d < 4; ++d)
#pragma unroll
          for (int g = 0; g < 4; ++g) {
            f32x4 v = {O[d][4 * g] * inv, O[d][4 * g + 1] * inv, O[d][4 * g + 2] * inv, O[d][4 * g + 3] * inv};
            *(f32x4*)(tmp + (size_t)((d * 4 + g) * 256) * 4) = v;
          }
      }
    }
    const float c2 = lam / l;
    float ss = 0.f;
    f32x16 O1[4];
#pragma unroll
    for (int d = 0; d < 4; ++d)
#pragma unroll
      for (int g = 0; g < 4; ++g) {
        const f32x4 v = *(const f32x4*)(tmp + (size_t)((d * 4 + g) * 256) * 4);
        const float vv[4] = {v.x, v.y, v.z, v.w};
#pragma unroll
        for (int j = 0; j < 4; ++j) {
          const float o = vv[j] - c2 * O[d][4 * g + j];
          O1[d][4 * g + j] = o;
          ss += o * o;
        }
      }
    ss += __shfl_xor(ss, 32);
    const float rstd = rsqrtf(ss * (1.f / 128.f) + EPSN) * (1.f - lambda_init);
    const int m = q0 + 32 * w + l31;
    const bfraw* gp = (const bfraw*)(P.ws + OFF_GA) + (size_t)m * 1024 + hd * 128 + 4 * hh;
    bfraw* yp = (bfraw*)(P.ws + OFF_H) + (size_t)m * 2048 + hd * 128 + 4 * hh;
    const float* sg = P.diff_subln + e * 128 + 4 * hh;
#pragma unroll
    for (int d = 0; d < 4; ++d)
#pragma unroll
      for (int g = 0; g < 4; ++g) {
        const f32x4 s4 = *(const f32x4*)(sg + 32 * d + 8 * g);
        const u32x2 gg = *(const u32x2*)(gp + 32 * d + 8 * g);
        const float y0 = O1[d][4 * g] * rstd * s4.x * bflo(gg.x);
        const float y1 = O1[d][4 * g + 1] * rstd * s4.y * bfhi(gg.x);
        const float y2 = O1[d][4 * g + 2] * rstd * s4.z * bflo(gg.y);
        const float y3 = O1[d][4 * g + 3] * rstd * s4.w * bfhi(gg.y);
        u32x2 u = {pk2(y0, y1), pk2(y2, y3)};
        *(u32x2*)(yp + 32 * d + 8 * g) = u; __builtin_amdgcn_sched_barrier(0);
      }
  }
}

DEV void phase_attn_odd(const Params& P, int layer, unsigned char* smem, int* s_item) {
  const int tid = threadIdx.x, lane = tid & 63, w = tid >> 6, l31 = lane & 31, hh = lane >> 5;
  bfraw* lds = (bfraw*)smem;
  int* ctr = (int*)(P.ws + OFF_CTR) + layer;
  const int NLAT = 16 * 128, NCX = (layer < 3) ? 16 * 2 : 0;
  const int total = NLAT + NCX;
  for (;;) {
    int it = next_item(ctr, s_item);
    if (it >= total) break;
    int hq, q0, nk;
    if (it < NLAT) { hq = it >> 7; q0 = 256 + 128 * (it & 127); nk = MT; }
    else { it -= NLAT; hq = it >> 1; q0 = 128 * (it & 1); nk = 256; }
    const int kv = hq >> 2;
    f32x16 O[4];
    float l;
    flash_block<128>((const bfraw*)(P.ws + OFF_QC) + (size_t)hq * MT * 128, (const bfraw*)(P.ws + OFF_KC) + (size_t)kv * MT * 128,
                     (const bfraw*)(P.ws + OFF_VTC) + (size_t)(kv * 128) * MT, q0, nk, lds, O, l);
    const float inv = 1.f / l;
    const int m = q0 + 32 * w + l31;
    const bfraw* gp = (const bfraw*)(P.ws + OFF_GC) + (size_t)m * 2048 + hq * 128 + 4 * hh;
    bfraw* yp = (bfraw*)(P.ws + OFF_H) + (size_t)m * 2048 + hq * 128 + 4 * hh;
#pragma unroll
    for (int d = 0; d < 4; ++d)
#pragma unroll
      for (int g = 0; g < 4; ++g) {
        const u32x2 gg = *(const u32x2*)(gp + 32 * d + 8 * g);
        const float y0 = O[d][4 * g] * inv * bflo(gg.x);
        const float y1 = O[d][4 * g + 1] * inv * bfhi(gg.x);
        const float y2 = O[d][4 * g + 2] * inv * bflo(gg.y);
        const float y3 = O[d][4 * g + 3] * inv * bfhi(gg.y);
        u32x2 u = {pk2(y0, y1), pk2(y2, y3)};
        *(u32x2*)(yp + 32 * d + 8 * g) = u; __builtin_amdgcn_sched_barrier(0);
      }
  }
}

DEV void phase_comb(const Params& P, int e) {
  const int lane = threadIdx.x & 63, w = threadIdx.x >> 6;
  const float* OFp = (const float*)(P.ws + OFF_OF);
  const float* OBp = (const float*)(P.ws + OFF_OB);
  const bfraw* GB = (const bfraw*)(P.ws + OFF_GB);
  bfraw* Y = (bfraw*)(P.ws + OFF_H);
  for (int idx = blockIdx.x * 4 + w; idx < MT * 4; idx += gridDim.x * 4) {
    const int m = idx >> 2, head = idx & 3;
    const size_t o = (size_t)m * 1024 + head * 256 + lane * 4;
    const f32x4 a = *(const f32x4*)(OFp + o);
    const f32x4 b = *(const f32x4*)(OBp + o);
    float z0 = a.x + b.x, z1 = a.y + b.y, z2 = a.z + b.z, z3 = a.w + b.w;
    const float mu = wave_sum(z0 + z1 + z2 + z3) * (1.f / 256.f);
    z0 -= mu; z1 -= mu; z2 -= mu; z3 -= mu;
    const float var = wave_sum(z0 * z0 + z1 * z1 + z2 * z2 + z3 * z3) * (1.f / 256.f);
    const float rstd = rsqrtf(var + EPSN);
    const f32x4 g4 = *(const f32x4*)(P.ret_gn + e * 1024 + head * 256 + lane * 4);
    const u32x2 gg = *(const u32x2*)(GB + o);
    u32x2 u = {pk2(z0 * rstd * g4.x * bflo(gg.x), z1 * rstd * g4.y * bfhi(gg.x)),
               pk2(z2 * rstd * g4.z * bflo(gg.y), z3 * rstd * g4.w * bfhi(gg.y))};
    *(u32x2*)(Y + (size_t)m * 2048 + 1024 + head * 256 + lane * 4) = u;
  }
}

__global__ void __launch_bounds__(256, 1) mega(Params P) {
  cg::grid_group grid = cg::this_grid();
  __shared__ __attribute__((aligned(16))) unsigned char smem[73728];
  __shared__ int s_item;
  phase0(P, smem);
  grid.sync();
  phase0b(P);
  grid.sync();
#pragma unroll 1
  for (int layer = 0; layer < 4; ++layer) {
    phase_norm(P, layer);
    grid.sync();
    phase_gemm(P, layer, layer & 1, smem);
    grid.sync();
    if (layer & 1) {
      phase_attn_odd(P, layer, smem, &s_item);
    } else {
      phase_attn_even(P, layer, smem, &s_item);
      grid.sync();
      phase_comb(P, layer >> 1);
    }
    grid.sync();
    phase_gemm(P, layer, 2, smem);
    grid.sync();
  }
  phase_final(P);
}

extern "C" void kernel_launch(void* const* d_in, const int* in_sizes, int n_in, void* d_out, int out_size, void* d_ws,
                              size_t ws_size, hipStream_t stream) {
  static int grid_blocks = 0;
  if (grid_blocks == 0) {
    if (n_in != 17 || ws_size < WS_END) {
      fprintf(stderr, "kernel_launch: need 17 inputs and >= %zu bytes of workspace; got %d inputs, %zu bytes\n", (size_t)WS_END, n_in, ws_size);
      grid_blocks = -1;
      return;
    }
    int dev = 0, cus = 0, per_cu = 0;
    hipGetDevice(&dev);
    hipDeviceGetAttribute(&cus, hipDeviceAttributeMultiprocessorCount, dev);
    hipOccupancyMaxActiveBlocksPerMultiprocessor(&per_cu, (const void*)mega, 256, 0);
    if (per_cu > 2) per_cu = 2;
    if (per_cu < 1) per_cu = 1;
    grid_blocks = cus * per_cu;
  }
  if (grid_blocks < 0) return;
  Params p{};
  p.x = (const float*)d_in[0]; p.c = (const float*)d_in[1]; p.ctx = (const float*)d_in[2]; p.c_ctx = (const float*)d_in[3];
  p.norm_g = (const float*)d_in[4]; p.w_mod = (const float*)d_in[5]; p.b_mod = (const float*)d_in[6];
  p.ev_w_in = (const float*)d_in[7]; p.ev_w_out = (const float*)d_in[8]; p.diff_lambda = (const float*)d_in[9];
  p.diff_subln = (const float*)d_in[10]; p.ret_decay = (const float*)d_in[11]; p.ret_gn = (const float*)d_in[12];
  p.od_w_in = (const float*)d_in[13]; p.od_w_out = (const float*)d_in[14]; p.qk_norm = (const float*)d_in[15];
  p.final_norm = (const float*)d_in[16];
  p.out = (float*)d_out; p.ws = (unsigned char*)d_ws;
  void* args[] = {&p};
  hipError_t e = hipLaunchCooperativeKernel((const void*)mega, dim3(grid_blocks), dim3(256), args, 0, stream);
  if (e != hipSuccess) fprintf(stderr, "cooperative launch failed: %s (grid %d)\n", hipGetErrorString(e), grid_blocks);
}
```

```cpp
#include <hip/hip_runtime.h>
#include <hip/hip_cooperative_groups.h>
#include <cstdio>
namespace cg = cooperative_groups;

typedef unsigned short bfraw;
typedef __attribute__((ext_vector_type(8))) __bf16 bf16x8;
typedef __attribute__((ext_vector_type(2))) __bf16 bf16x2;
typedef __attribute__((ext_vector_type(2))) float f32x2;
typedef __attribute__((ext_vector_type(16))) float f32x16;
typedef __attribute__((ext_vector_type(4))) float f32x4;
typedef __attribute__((ext_vector_type(4))) unsigned u32x4;
typedef __attribute__((ext_vector_type(2))) unsigned u32x2;

#define DEV static __device__ __forceinline__

constexpr int MT = 16640;
constexpr int DM = 2048;
constexpr float LOG2E = 1.4426950408889634f;
constexpr float EPSN = 1e-6f;

constexpr size_t OFF_WT_EVIN  = 0;
constexpr size_t OFF_WT_EVOUT = OFF_WT_EVIN + (size_t)2 * 7168 * 2048 * 2;
constexpr size_t OFF_WT_ODIN  = OFF_WT_EVOUT + (size_t)2 * 2048 * 2048 * 2;
constexpr size_t OFF_WT_ODOUT = OFF_WT_ODIN + (size_t)2 * 5120 * 2048 * 2;
constexpr size_t OFF_MODPART  = OFF_WT_ODOUT + (size_t)2 * 2048 * 2048 * 2;
constexpr size_t OFF_MODV     = OFF_MODPART + (size_t)16 * 4 * 2 * 6144 * 4;
constexpr size_t OFF_ROPE     = OFF_MODV + (size_t)4 * 2 * 6144 * 4;
constexpr size_t OFF_CTR      = OFF_ROPE + (size_t)(8192 + 16384) * 4;
constexpr size_t OFF_CTXRES   = OFF_CTR + 256;
constexpr size_t OFF_H        = OFF_CTXRES + (size_t)256 * 2048 * 4;
constexpr size_t OFF_PROJ     = OFF_H + (size_t)MT * 2048 * 2;
constexpr size_t SZ_A         = (size_t)MT * 1024 * 2;
constexpr size_t SZ_B         = (size_t)MT * 512 * 2;
constexpr size_t OFF_QA  = OFF_PROJ;
constexpr size_t OFF_KA  = OFF_QA + SZ_A;
constexpr size_t OFF_VTA = OFF_KA + SZ_A;
constexpr size_t OFF_GA  = OFF_VTA + SZ_A;
constexpr size_t OFF_QB  = OFF_GA + SZ_A;
constexpr size_t OFF_KB  = OFF_QB + SZ_B;
constexpr size_t OFF_KBT = OFF_KB + SZ_B;
constexpr size_t OFF_VTB = OFF_KBT + SZ_B;
constexpr size_t OFF_GB  = OFF_VTB + SZ_A;
constexpr size_t OFF_PROJ_END = OFF_GB + SZ_A;
constexpr size_t OFF_QC  = OFF_PROJ;
constexpr size_t OFF_KC  = OFF_QC + 2 * SZ_A;
constexpr size_t OFF_VTC = OFF_KC + SZ_B;
constexpr size_t OFF_GC  = OFF_VTC + SZ_B;
constexpr size_t OFF_OF  = OFF_PROJ_END;
constexpr size_t OFF_OB  = OFF_OF + (size_t)MT * 1024 * 4;
constexpr size_t OFF_DTMP = OFF_OB + (size_t)MT * 1024 * 4;
constexpr size_t WS_END  = OFF_DTMP + (size_t)1024 * 256 * 64 * 4;

struct Params {
  const float *x, *c, *ctx, *c_ctx, *norm_g, *w_mod, *b_mod, *ev_w_in, *ev_w_out, *diff_lambda, *diff_subln,
      *ret_decay, *ret_gn, *od_w_in, *od_w_out, *qk_norm, *final_norm;
  float* out;
  unsigned char* ws;
};

DEV f32x16 mfma(bf16x8 a, bf16x8 b, f32x16 c) { return __builtin_amdgcn_mfma_f32_32x32x16_bf16(a, b, c, 0, 0, 0); }
DEV unsigned pk2(float a, float b) {
  f32x2 v = {a, b};
  bf16x2 r = __builtin_convertvector(v, bf16x2);
  return __builtin_bit_cast(unsigned, r);
}
DEV u32x4 ldg(const bfraw* ubase, unsigned voff) { return *(const u32x4*)((const char*)ubase + voff); }
DEV int otid() { int t = threadIdx.x; asm volatile("" : "+v"(t)); return t; }
DEV float bflo(unsigned u) { return __uint_as_float(u << 16); }
DEV float bfhi(unsigned u) { return __uint_as_float(u & 0xffff0000u); }
DEV bf16x8 pack8(float a0, float a1, float a2, float a3, float a4, float a5, float a6, float a7) {
  u32x4 u = {pk2(a0, a1), pk2(a2, a3), pk2(a4, a5), pk2(a6, a7)};
  return __builtin_bit_cast(bf16x8, u);
}
DEV bfraw f2bf(float a) { return (bfraw)(pk2(a, 0.f) & 0xffffu); }
DEV float fexp2(float x) { return __builtin_amdgcn_exp2f(x); }
DEV float wave_sum(float v, int lane) {
#pragma unroll
  for (int o = 1; o < 64; o <<= 1) v += __int_as_float(__builtin_amdgcn_ds_bpermute((lane ^ o) << 2, __float_as_int(v)));
  return v;
}
DEV float xsum32(float x) {
  const u32x2 r = __builtin_amdgcn_permlane32_swap(__float_as_uint(x), __float_as_uint(x), false, false);
  return __uint_as_float(r.x) + __uint_as_float(r.y);
}
DEV float xmax32(float x) {
  const u32x2 r = __builtin_amdgcn_permlane32_swap(__float_as_uint(x), __float_as_uint(x), false, false);
  return fmaxf(__uint_as_float(r.x), __uint_as_float(r.y));
}
DEV float uni(float x) { return __int_as_float(__builtin_amdgcn_readfirstlane(__float_as_int(x))); }
DEV float siluf(float v) { return v / (1.f + __expf(-v)); }
DEV int perm16(int m) {
  int b = (m >> 2) & 3;
  int b2 = ((b & 1) << 1) | (b >> 1);
  return (m & ~12) | (b2 << 2);
}

DEV const float* res_src(const Params& P, int layer, int row) {
  if (row < 256) return (layer == 0 ? P.ctx : (const float*)(P.ws + OFF_CTXRES)) + (size_t)row * DM;
  return (layer == 0 ? P.x : (const float*)P.out) + (size_t)(row - 256) * DM;
}
DEV float* res_dst(const Params& P, int row) {
  if (row < 256) return (float*)(P.ws + OFF_CTXRES) + (size_t)row * DM;
  return P.out + (size_t)(row - 256) * DM;
}

DEV void phase0(const Params& P, unsigned char* smem) {
  const int tid = otid();
  const int gtid = blockIdx.x * 256 + tid, gsz = gridDim.x * 256;
  if (gtid < 16) ((int*)(P.ws + OFF_CTR))[gtid] = 0;
  float* rope = (float*)(P.ws + OFF_ROPE);
  for (int i = gtid; i < 4096 + 8192; i += gsz) {
    int pos, f; float inv; float *pc, *ps;
    if (i < 4096) { pos = i >> 4; f = i & 15; inv = exp2f(-(float)f * (13.287712379549449f / 16.f)); pc = rope + i; ps = rope + 4096 + i; }
    else { int j = i - 4096; pos = j >> 5; f = j & 31; inv = exp2f(-(float)f * (13.287712379549449f / 32.f)); pc = rope + 8192 + j; ps = rope + 16384 + j; }
    float ang = (float)pos * inv;
    double a = (double)ang;
    double kk = rint(a * 0.15915494309189535);
    float r = (float)(a - kk * 6.283185307179586);
    *pc = __cosf(r); *ps = __sinf(r);
  }
  const int NG = 4 * 16 * 6, NTT = 16384;
  for (int it = blockIdx.x; it < NG + NTT; it += gridDim.x) {
    if (it < NG) {
      const int layer = it / 96, rem = it % 96, kc = rem / 6, ng = rem % 6;
      const int n = ng * 1024 + tid * 4;
      const float* W = P.w_mod + ((size_t)layer * 2048 + kc * 128) * 6144 + n;
      f32x4 al = {0.f, 0.f, 0.f, 0.f}, ac = {0.f, 0.f, 0.f, 0.f};
#pragma unroll 8
      for (int k = 0; k < 128; ++k) {
        const float cl = P.c[kc * 128 + k], cc = P.c_ctx[kc * 128 + k];
        const float sl = siluf(cl), sx = siluf(cc);
        const f32x4 w4 = *(const f32x4*)(W + (size_t)k * 6144);
        al.x += sl * w4.x; al.y += sl * w4.y; al.z += sl * w4.z; al.w += sl * w4.w;
        ac.x += sx * w4.x; ac.y += sx * w4.y; ac.z += sx * w4.z; ac.w += sx * w4.w;
      }
      float* part = (float*)(P.ws + OFF_MODPART) + ((size_t)(kc * 4 + layer) * 2) * 6144;
      *(f32x4*)(part + n) = al;
      *(f32x4*)(part + 6144 + n) = ac;
    } else {
      int t = it - NG;
      const float* src; bfraw* dst; int N;
      if (t < 7168) { int l = t / 3584; t -= l * 3584; N = 7168; src = P.ev_w_in + (size_t)l * 2048 * 7168; dst = (bfraw*)(P.ws + OFF_WT_EVIN) + (size_t)l * 7168 * 2048; }
      else if (t < 7168 + 2048) { t -= 7168; int l = t / 1024; t -= l * 1024; N = 2048; src = P.ev_w_out + (size_t)l * 2048 * 2048; dst = (bfraw*)(P.ws + OFF_WT_EVOUT) + (size_t)l * 2048 * 2048; }
      else if (t < 7168 + 2048 + 5120) { t -= 9216; int l = t / 2560; t -= l * 2560; N = 5120; src = P.od_w_in + (size_t)l * 2048 * 5120; dst = (bfraw*)(P.ws + OFF_WT_ODIN) + (size_t)l * 5120 * 2048; }
      else { t -= 14336; int l = t / 1024; t -= l * 1024; N = 2048; src = P.od_w_out + (size_t)l * 2048 * 2048; dst = (bfraw*)(P.ws + OFF_WT_ODOUT) + (size_t)l * 2048 * 2048; }
      const int ntn = N >> 6;
      const int ntile = t % ntn, ktile = t / ntn;
      float* sT = (float*)smem;
#pragma unroll
      for (int j = 0; j < 4; ++j) {
        const int idx = tid + 256 * j, krow = idx >> 4, c4 = idx & 15;
        const f32x4 v = *(const f32x4*)(src + (size_t)(ktile * 64 + krow) * N + ntile * 64 + c4 * 4);
        float* d = sT + krow * 65 + c4 * 4;
        d[0] = v.x; d[1] = v.y; d[2] = v.z; d[3] = v.w;
      }
      __syncthreads();
#pragma unroll
      for (int j = 0; j < 2; ++j) {
        const int idx = tid + 256 * j, kg = idx & 7, n = idx >> 3;
        const float* s = sT + (kg * 8) * 65 + n;
        u32x4 u = {pk2(s[0], s[65]), pk2(s[130], s[195]), pk2(s[260], s[325]), pk2(s[390], s[455])};
        *(u32x4*)(dst + (size_t)(ntile * 64 + n) * 2048 + ktile * 64 + kg * 8) = u;
      }
      __syncthreads();
    }
  }
}

DEV void phase0b(const Params& P) {
  const int gtid = blockIdx.x * 256 + otid(), gsz = gridDim.x * 256;
  const float* part = (const float*)(P.ws + OFF_MODPART);
  float* modv = (float*)(P.ws + OFF_MODV);
  for (int i = gtid; i < 4 * 2 * 6144; i += gsz) {
    const int layer = i / 12288, rem = i % 12288, which = rem / 6144, n = rem % 6144;
    float s = P.b_mod[layer * 6144 + n];
#pragma unroll
    for (int kc = 0; kc < 16; ++kc) s += part[((size_t)(kc * 4 + layer) * 2 + which) * 6144 + n];
    modv[i] = s;
  }
}

DEV void phase_norm(const Params& P, int layer) {
  const int tid = otid(), lane = tid & 63, w = tid >> 6;
  const float* g = P.norm_g + layer * 2048;
  const float* modv = (const float*)(P.ws + OFF_MODV) + (size_t)layer * 2 * 6144;
  bfraw* H = (bfraw*)(P.ws + OFF_H);
  for (int row = blockIdx.x * 4 + w; row < MT; row += gridDim.x * 4) {
    const float* src = res_src(P, layer, row);
    const float* mv = modv + (row < 256 ? 6144 : 0);
    f32x4 v[8];
    float ss = 0.f;
#pragma unroll
    for (int it = 0; it < 8; ++it) {
      v[it] = *(const f32x4*)(src + (it * 64 + lane) * 4);
      ss += v[it].x * v[it].x + v[it].y * v[it].y + v[it].z * v[it].z + v[it].w * v[it].w;
    }
    ss = wave_sum(ss, lane);
    const float rstd = rsqrtf(ss * (1.f / 2048.f) + EPSN);
#pragma unroll
    for (int it = 0; it < 8; ++it) {
      const int c = (it * 64 + lane) * 4;
      const f32x4 g4 = *(const f32x4*)(g + c);
      const f32x4 sh = *(const f32x4*)(mv + c);
      const f32x4 sc = *(const f32x4*)(mv + 2048 + c);
      const float y0 = v[it].x * rstd * g4.x * (1.f + sc.x) + sh.x;
      const float y1 = v[it].y * rstd * g4.y * (1.f + sc.y) + sh.y;
      const float y2 = v[it].z * rstd * g4.z * (1.f + sc.z) + sh.z;
      const float y3 = v[it].w * rstd * g4.w * (1.f + sc.w) + sh.w;
      u32x2 u = {pk2(y0, y1), pk2(y2, y3)};
      *(u32x2*)(H + (size_t)row * 2048 + c) = u;
    }
  }
}

DEV void phase_final(const Params& P) {
  const int tid = otid(), lane = tid & 63, w = tid >> 6;
  for (int row = blockIdx.x * 4 + w; row < 16384; row += gridDim.x * 4) {
    float* src = P.out + (size_t)row * DM;
    f32x4 v[8];
    float ss = 0.f;
#pragma unroll
    for (int it = 0; it < 8; ++it) {
      v[it] = *(const f32x4*)(src + (it * 64 + lane) * 4);
      ss += v[it].x * v[it].x + v[it].y * v[it].y + v[it].z * v[it].z + v[it].w * v[it].w;
    }
    ss = wave_sum(ss, lane);
    const float rstd = rsqrtf(ss * (1.f / 2048.f) + EPSN);
#pragma unroll
    for (int it = 0; it < 8; ++it) {
      const int c = (it * 64 + lane) * 4;
      const f32x4 g4 = *(const f32x4*)(P.final_norm + c);
      f32x4 y = {v[it].x * rstd * g4.x, v[it].y * rstd * g4.y, v[it].z * rstd * g4.z, v[it].w * rstd * g4.w};
      *(f32x4*)(src + c) = y;
    }
  }
}

template <bool FEAT>
DEV void gemm_main(const bfraw* A, const bfraw* W, int m0, int n0, bfraw* lds, f32x16 (&acc)[4]) {
  const int tid = otid(), lane = tid & 63, w = tid >> 6, l31 = lane & 31, hh = lane >> 5;
  const int srow = tid >> 3, scol = (tid & 7) * 8;
  const bfraw* ap = A + (size_t)m0 * 2048;
  const bfraw* wp = W + (size_t)n0 * 2048;
  const unsigned goff = (unsigned)(srow * 2048 + scol) * 2u;
  u32x4 ra[4], rw[4];
#pragma unroll
  for (int j = 0; j < 4; ++j) {
    ra[j] = ldg(ap + (size_t)j * 32 * 2048, goff);
    rw[j] = ldg(wp + (size_t)j * 32 * 2048, goff);
  }
#pragma unroll
  for (int nt = 0; nt < 4; ++nt)
#pragma unroll
    for (int r = 0; r < 16; ++r) acc[nt][r] = 0.f;
#pragma unroll
  for (int j = 0; j < 4; ++j) {
    *(u32x4*)(lds + (srow + 32 * j) * 72 + scol) = ra[j];
    *(u32x4*)(lds + 9216 + (srow + 32 * j) * 72 + scol) = rw[j];
  }
  __syncthreads();
#pragma unroll 1
  for (int kt = 0; kt < 32; ++kt) {
    const bfraw* cA = lds + (kt & 1) * 18432;
    const bfraw* cB = cA + 9216;
    if (kt + 1 < 32) {
#pragma unroll
      for (int j = 0; j < 4; ++j) {
        ra[j] = ldg(ap + (size_t)j * 32 * 2048 + (kt + 1) * 64, goff);
        rw[j] = ldg(wp + (size_t)j * 32 * 2048 + (kt + 1) * 64, goff);
      }
    }
#pragma unroll
    for (int s = 0; s < 4; ++s) {
      const bf16x8 fm = *(const bf16x8*)(cA + (32 * w + l31) * 72 + s * 16 + hh * 8);
#pragma unroll
      for (int nt = 0; nt < 4; ++nt) {
        const bf16x8 fn = *(const bf16x8*)(cB + (32 * nt + l31) * 72 + s * 16 + hh * 8);
        if (FEAT) acc[nt] = mfma(fm, fn, acc[nt]);
        else acc[nt] = mfma(fn, fm, acc[nt]);
      }
    }
    if (kt + 1 < 32) {
      bfraw* nA = lds + ((kt + 1) & 1) * 18432;
#pragma unroll
      for (int j = 0; j < 4; ++j) {
        *(u32x4*)(nA + (srow + 32 * j) * 72 + scol) = ra[j];
        *(u32x4*)(nA + 9216 + (srow + 32 * j) * 72 + scol) = rw[j];
      }
    }
    __syncthreads();
  }
}

DEV void phase_gemm(const Params& P, int layer, int kind, unsigned char* smem) {
  const int tid = otid(), lane = tid & 63, w = tid >> 6, l31 = lane & 31, hh = lane >> 5;
  bfraw* lds = (bfraw*)smem;
  const int eo = layer >> 1;
  const bfraw* A = (const bfraw*)(P.ws + OFF_H);
  const bfraw* W;
  int NTN, mt0 = 0;
  if (kind == 0) { W = (const bfraw*)(P.ws + OFF_WT_EVIN) + (size_t)eo * 7168 * 2048; NTN = 56; }
  else if (kind == 1) { W = (const bfraw*)(P.ws + OFF_WT_ODIN) + (size_t)eo * 5120 * 2048; NTN = 40; }
  else { W = (const bfraw*)(P.ws + ((layer & 1) ? OFF_WT_ODOUT : OFF_WT_EVOUT)) + (size_t)eo * 2048 * 2048; NTN = 16; if (layer == 3) mt0 = 2; }
  const float* rope = (const float*)(P.ws + OFF_ROPE);
  const int ntiles = (130 - mt0) * NTN;
  for (int t = blockIdx.x; t < ntiles; t += gridDim.x) {
    const int mt = mt0 + t / NTN, tn = t % NTN;
    const int m0 = mt * 128, n0 = tn * 128;
    f32x16 acc[4];
    int vcol = -1; bfraw* vdst = nullptr;
    if (kind == 0) {
      if (tn >= 16 && tn < 24) { vcol = (tn - 16) * 128; vdst = (bfraw*)(P.ws + OFF_VTA); }
      else if (tn >= 40 && tn < 48) { vcol = (tn - 40) * 128; vdst = (bfraw*)(P.ws + OFF_VTB); }
    } else if (kind == 1) {
      if (tn >= 20 && tn < 24) { vcol = (tn - 20) * 128; vdst = (bfraw*)(P.ws + OFF_VTC); }
    }
    if (vcol >= 0) {
      gemm_main<true>(A, W, m0, n0, lds, acc);
#pragma unroll
      for (int nt = 0; nt < 4; ++nt) {
        bfraw* rowp = vdst + (size_t)(vcol + 32 * nt + l31) * MT;
#pragma unroll
        for (int g = 0; g < 4; ++g) {
          const int pos = m0 + 32 * w + 16 * (g >> 1) + 8 * hh + 4 * (g & 1);
          u32x2 u = {pk2(acc[nt][4 * g], acc[nt][4 * g + 1]), pk2(acc[nt][4 * g + 2], acc[nt][4 * g + 3])};
          *(u32x2*)(rowp + pos) = u; __builtin_amdgcn_sched_barrier(0);
        }
      }
      continue;
    }
    gemm_main<false>(A, W, m0, n0, lds, acc);
    const int m = m0 + 32 * w + l31;
    const bool lat = m0 >= 256;
    const int tl = m - 256;
    const int prow = (tl >> 6) & 255, pcol = tl & 63;
    if (kind == 2) {
      const float* gate = (const float*)(P.ws + OFF_MODV) + ((size_t)layer * 2 + (lat ? 0 : 1)) * 6144 + 4096;
      const float* srow_ = res_src(P, layer, m);
      float* drow = res_dst(P, m);
#pragma unroll
      for (int nt = 0; nt < 4; ++nt)
#pragma unroll
        for (int g = 0; g < 4; ++g) {
          const int n = n0 + 32 * nt + 8 * g + 4 * hh;
          f32x4 xo = *(const f32x4*)(srow_ + n);
          const f32x4 gt = *(const f32x4*)(gate + n);
          xo.x += gt.x * acc[nt][4 * g]; xo.y += gt.y * acc[nt][4 * g + 1];
          xo.z += gt.z * acc[nt][4 * g + 2]; xo.w += gt.w * acc[nt][4 * g + 3];
          *(f32x4*)(drow + n) = xo; __builtin_amdgcn_sched_barrier(0);
        }
      continue;
    }
    if (kind == 0) {
      if (tn < 16) {
        const bool isq = tn < 8;
        const int hb = 2 * (isq ? tn : tn - 8);
        bfraw* dst = (bfraw*)(P.ws + (isq ? OFF_QA : OFF_KA));
        const float scl = isq ? 0.125f * LOG2E : 1.f;
        if (lat) {
#pragma unroll
          for (int nt = 0; nt < 4; ++nt) {
            const int pos = (nt & 1) ? pcol : prow;
#pragma unroll
            for (int g = 0; g < 2; ++g) {
              const f32x4 c4 = *(const f32x4*)(rope + pos * 16 + 8 * g + 4 * hh);
              const f32x4 s4 = *(const f32x4*)(rope + 4096 + pos * 16 + 8 * g + 4 * hh);
              const float cc[4] = {c4.x, c4.y, c4.z, c4.w}, sn[4] = {s4.x, s4.y, s4.z, s4.w};
#pragma unroll
              for (int j = 0; j < 4; ++j) {
                const float x1 = acc[nt][4 * g + j], x2 = acc[nt][4 * g + j + 8];
                acc[nt][4 * g + j] = x1 * cc[j] - x2 * sn[j];
                acc[nt][4 * g + j + 8] = x1 * sn[j] + x2 * cc[j];
              }
              __builtin_amdgcn_sched_barrier(0);
            }
          }
        }
#pragma unroll
        for (int nt = 0; nt < 4; ++nt) {
          bfraw* rp = dst + ((size_t)(hb + (nt >> 1)) * MT + m) * 64 + (nt & 1) * 32 + 4 * hh;
#pragma unroll
          for (int g = 0; g < 4; ++g) {
            u32x2 u = {pk2(acc[nt][4 * g] * scl, acc[nt][4 * g + 1] * scl), pk2(acc[nt][4 * g + 2] * scl, acc[nt][4 * g + 3] * scl)};
            *(u32x2*)(rp + 8 * g) = u; __builtin_amdgcn_sched_barrier(0);
          }
        }
      } else if (tn < 32 || tn >= 48) {
        bfraw* dst = (tn < 32) ? (bfraw*)(P.ws + OFF_GA) + (size_t)m * 1024 + (tn - 24) * 128
                               : (bfraw*)(P.ws + OFF_GB) + (size_t)m * 1024 + (tn - 48) * 128;
#pragma unroll
        for (int nt = 0; nt < 4; ++nt)
#pragma unroll
          for (int g = 0; g < 4; ++g) {
            u32x2 u = {pk2(siluf(acc[nt][4 * g]), siluf(acc[nt][4 * g + 1])), pk2(siluf(acc[nt][4 * g + 2]), siluf(acc[nt][4 * g + 3]))};
            *(u32x2*)(dst + 32 * nt + 8 * g + 4 * hh) = u; __builtin_amdgcn_sched_barrier(0);
          }
      } else if (tn < 36) {
        bfraw* rp = (bfraw*)(P.ws + OFF_QB) + ((size_t)(tn - 32) * MT + m) * 128 + 4 * hh;
#pragma unroll
        for (int nt = 0; nt < 4; ++nt)
#pragma unroll
          for (int g = 0; g < 4; ++g) {
            u32x2 u = {pk2(acc[nt][4 * g], acc[nt][4 * g + 1]), pk2(acc[nt][4 * g + 2], acc[nt][4 * g + 3])};
            *(u32x2*)(rp + 32 * nt + 8 * g) = u; __builtin_amdgcn_sched_barrier(0);
          }
      } else {
        const int head = tn - 36;
        const float scl = 0.08838834764831845f;
        bfraw* rp = (bfraw*)(P.ws + OFF_KB) + ((size_t)head * MT + m) * 128 + 4 * hh;
        bfraw* tp = (bfraw*)(P.ws + OFF_KBT) + (size_t)(head * 128) * MT + perm16(m);
#pragma unroll
        for (int nt = 0; nt < 4; ++nt)
#pragma unroll
          for (int g = 0; g < 4; ++g) {
            const unsigned u0 = pk2(acc[nt][4 * g] * scl, acc[nt][4 * g + 1] * scl);
            const unsigned u1 = pk2(acc[nt][4 * g + 2] * scl, acc[nt][4 * g + 3] * scl);
            u32x2 u = {u0, u1};
            *(u32x2*)(rp + 32 * nt + 8 * g) = u; __builtin_amdgcn_sched_barrier(0);
            const int nl = 32 * nt + 8 * g + 4 * hh;
            tp[(size_t)(nl + 0) * MT] = (bfraw)(u0 & 0xffffu);
            tp[(size_t)(nl + 1) * MT] = (bfraw)(u0 >> 16);
            tp[(size_t)(nl + 2) * MT] = (bfraw)(u1 & 0xffffu);
            tp[(size_t)(nl + 3) * MT] = (bfraw)(u1 >> 16); __builtin_amdgcn_sched_barrier(0);
          }
      }
    } else {
      if (tn < 20) {
        const bool isq = tn < 16;
        const int head = isq ? tn : tn - 16;
        const float* qg = P.qk_norm + eo * 256 + (isq ? 0 : 128);
        bfraw* rp = (bfraw*)(P.ws + (isq ? OFF_QC : OFF_KC)) + ((size_t)head * MT + m) * 128 + 4 * hh;
        const float scl = isq ? 0.08838834764831845f * LOG2E : 1.f;
        float ss = 0.f;
#pragma unroll
        for (int nt = 0; nt < 4; ++nt)
#pragma unroll
          for (int r = 0; r < 16; ++r) ss += acc[nt][r] * acc[nt][r];
        ss = xsum32(ss);
        const float rstd = rsqrtf(ss * (1.f / 128.f) + EPSN);
#pragma unroll
        for (int nt = 0; nt < 4; ++nt)
#pragma unroll
          for (int g = 0; g < 4; ++g) {
            const f32x4 g4 = *(const f32x4*)(qg + 32 * nt + 8 * g + 4 * hh);
            acc[nt][4 * g] *= rstd * g4.x; acc[nt][4 * g + 1] *= rstd * g4.y;
            acc[nt][4 * g + 2] *= rstd * g4.z; acc[nt][4 * g + 3] *= rstd * g4.w; __builtin_amdgcn_sched_barrier(0);
          }
        if (lat) {
#pragma unroll
          for (int p = 0; p < 2; ++p) {
            const int pos = p ? pcol : prow;
#pragma unroll
            for (int g = 0; g < 4; ++g) {
              const f32x4 c4 = *(const f32x4*)(rope + 8192 + pos * 32 + 8 * g + 4 * hh);
              const f32x4 s4 = *(const f32x4*)(rope + 16384 + pos * 32 + 8 * g + 4 * hh);
              const float cc[4] = {c4.x, c4.y, c4.z, c4.w}, sn[4] = {s4.x, s4.y, s4.z, s4.w};
#pragma unroll
              for (int j = 0; j < 4; ++j) {
                const float x1 = acc[2 * p][4 * g + j], x2 = acc[2 * p + 1][4 * g + j];
                acc[2 * p][4 * g + j] = x1 * cc[j] - x2 * sn[j];
                acc[2 * p + 1][4 * g + j] = x1 * sn[j] + x2 * cc[j];
              }
              __builtin_amdgcn_sched_barrier(0);
            }
          }
        }
#pragma unroll
        for (int nt = 0; nt < 4; ++nt)
#pragma unroll
          for (int g = 0; g < 4; ++g) {
            u32x2 u = {pk2(acc[nt][4 * g] * scl, acc[nt][4 * g + 1] * scl), pk2(acc[nt][4 * g + 2] * scl, acc[nt][4 * g + 3] * scl)};
            *(u32x2*)(rp + 32 * nt + 8 * g) = u; __builtin_amdgcn_sched_barrier(0);
          }
      } else {
        bfraw* dst = (bfraw*)(P.ws + OFF_GC) + (size_t)m * 2048 + (tn - 24) * 128;
#pragma unroll
        for (int nt = 0; nt < 4; ++nt)
#pragma unroll
          for (int g = 0; g < 4; ++g) {
            u32x2 u = {pk2(siluf(acc[nt][4 * g]), siluf(acc[nt][4 * g + 1])), pk2(siluf(acc[nt][4 * g + 2]), siluf(acc[nt][4 * g + 3]))};
            *(u32x2*)(dst + 32 * nt + 8 * g + 4 * hh) = u; __builtin_amdgcn_sched_barrier(0);
          }
      }
    }
  }
}

template <int D>
DEV void flash_block(const bfraw* Qh, const bfraw* Kh, const bfraw* Vt, int q0, int nk, bfraw* lds, f32x16 (&O)[4], float& lsum) {
  constexpr int KS = D + 8;
  constexpr int KT = 64 * KS;
  constexpr int STG = KT + 128 * 72;
  constexpr int KCH = D / 8;
  constexpr int NKC = 64 * KCH / 256;
  const int tid = otid(), lane = tid & 63, w = tid >> 6, l31 = lane & 31, hh = lane >> 5;
  bf16x8 qf[D / 16];
  {
    const bfraw* qp = Qh + (size_t)(q0 + 32 * w + l31) * D + 8 * hh;
#pragma unroll
    for (int s = 0; s < D / 16; ++s) qf[s] = *(const bf16x8*)(qp + 16 * s);
  }
#pragma unroll
  for (int d = 0; d < 4; ++d)
#pragma unroll
    for (int r = 0; r < 16; ++r) O[d][r] = 0.f;
  lsum = 0.f;
  float mrun = -INFINITY;
  u32x4 rk[NKC], rv[4];
  const int krow = tid / KCH, kcol = (tid % KCH) * 8;
  const int vrow = tid >> 3, vcol = (tid & 7) * 8;
  const unsigned koff = (unsigned)(krow * D + kcol) * 2u, voff = (unsigned)(vrow * MT + vcol) * 2u;
#pragma unroll
  for (int j = 0; j < NKC; ++j) rk[j] = ldg(Kh + (size_t)j * (256 / KCH) * D, koff);
#pragma unroll
  for (int j = 0; j < 4; ++j) rv[j] = ldg(Vt + (size_t)j * 32 * MT, voff);
#pragma unroll
  for (int j = 0; j < NKC; ++j) *(u32x4*)(lds + (krow + j * (256 / KCH)) * KS + kcol) = rk[j];
#pragma unroll
  for (int j = 0; j < 4; ++j) *(u32x4*)(lds + KT + (vrow + 32 * j) * 72 + vcol) = rv[j];
  __syncthreads();
  const int ntile = nk >> 6;
#pragma unroll 1
  for (int t = 0; t < ntile; ++t) {
    const bfraw* sK = lds + (t & 1) * STG;
    const bfraw* sV = sK + KT;
    if (t + 1 < ntile) {
      const int key0 = (t + 1) * 64;
#pragma unroll
      for (int j = 0; j < NKC; ++j) rk[j] = ldg(Kh + (size_t)(key0 + j * (256 / KCH)) * D, koff);
#pragma unroll
      for (int j = 0; j < 4; ++j) rv[j] = ldg(Vt + (size_t)j * 32 * MT + key0, voff);
    }
    f32x16 sc[2];
#pragma unroll
    for (int kt = 0; kt < 2; ++kt) {
#pragma unroll
      for (int r = 0; r < 16; ++r) sc[kt][r] = 0.f;
#pragma unroll
      for (int s = 0; s < D / 16; ++s) {
        const bf16x8 kf = *(const bf16x8*)(sK + (32 * kt + l31) * KS + 16 * s + 8 * hh);
        sc[kt] = mfma(kf, qf[s], sc[kt]);
      }
    }
    float mx = sc[0][0];
#pragma unroll
    for (int r = 1; r < 16; ++r) mx = fmaxf(mx, sc[0][r]);
#pragma unroll
    for (int r = 0; r < 16; ++r) mx = fmaxf(mx, sc[1][r]);
    mx = xmax32(mx);
    const float mnew = fmaxf(mrun, mx);
    const float alpha = fexp2(mrun - mnew);
    mrun = mnew;
    float ps = 0.f;
#pragma unroll
    for (int kt = 0; kt < 2; ++kt)
#pragma unroll
      for (int r = 0; r < 16; ++r) {
        const float p = fexp2(sc[kt][r] - mnew);
        sc[kt][r] = p;
        ps += p;
      }
    lsum = lsum * alpha + ps;
#pragma unroll
    for (int d = 0; d < 4; ++d)
#pragma unroll
      for (int r = 0; r < 16; ++r) O[d][r] *= alpha;
#pragma unroll
    for (int kt = 0; kt < 2; ++kt)
#pragma unroll
      for (int tt = 0; tt < 2; ++tt) {
        const bf16x8 pf = pack8(sc[kt][8 * tt], sc[kt][8 * tt + 1], sc[kt][8 * tt + 2], sc[kt][8 * tt + 3],
                                sc[kt][8 * tt + 4], sc[kt][8 * tt + 5], sc[kt][8 * tt + 6], sc[kt][8 * tt + 7]);
#pragma unroll
        for (int d = 0; d < 4; ++d) {
          const bf16x8 vf = *(const bf16x8*)(sV + (32 * d + l31) * 72 + 32 * kt + 16 * tt + 8 * hh);
          O[d] = mfma(vf, pf, O[d]);
        }
      }
    if (t + 1 < ntile) {
      bfraw* nK = lds + ((t + 1) & 1) * STG;
#pragma unroll
      for (int j = 0; j < NKC; ++j) *(u32x4*)(nK + (krow + j * (256 / KCH)) * KS + kcol) = rk[j];
#pragma unroll
      for (int j = 0; j < 4; ++j) *(u32x4*)(nK + KT + (vrow + 32 * j) * 72 + vcol) = rv[j];
    }
    __syncthreads();
  }
  lsum = xsum32(lsum);
}

DEV void chain_item(const Params& P, int e, int it, bfraw* lds) {
  const int tid = otid(), lane = tid & 63, w = tid >> 6, l31 = lane & 31, hh = lane >> 5;
  const int dir = it >> 3, head = (it >> 1) & 3, half = it & 1;
  const float lg2 = -__expf(P.ret_decay[e * 8 + dir * 4 + head]) * LOG2E;
  const float cd = exp2f(lg2 * 64.f);
  bfraw* sQ = lds;
  bfraw* sK = lds + 8704;
  bfraw* sKt = lds + 17408;
  bfraw* sV = lds + 26624;
  const bfraw* Qg = (const bfraw*)(P.ws + OFF_QB) + (size_t)head * MT * 128;
  const bfraw* Kg = (const bfraw*)(P.ws + OFF_KB) + (size_t)head * MT * 128;
  const bfraw* Ktg = (const bfraw*)(P.ws + OFF_KBT) + (size_t)(head * 128) * MT;
  const bfraw* Vg = (const bfraw*)(P.ws + OFF_VTB) + (size_t)(head * 256 + half * 128) * MT;
  float* og = (float*)(P.ws + (dir ? OFF_OB : OFF_OF));
  f32x16 St[4];
#pragma unroll
  for (int d = 0; d < 4; ++d)
#pragma unroll
    for (int r = 0; r < 16; ++r) St[d][r] = 0.f;
  u32x4 rq[4], rk[4], rkt[4], rv[4];
  const int qrow = tid >> 4, qcol = (tid & 15) * 8;
  const int trow = tid >> 3, tcol = (tid & 7) * 8;
  const unsigned qoff = (unsigned)(qrow * 128 + qcol) * 2u, toff = (unsigned)(trow * MT + tcol) * 2u;
#pragma unroll 1
  for (int n = 0; n < 260; ++n) {
    const int r0 = dir == 0 ? 64 * n : (n < 4 ? 192 - 64 * n : 16576 - 64 * (n - 4));
    float lg2v = lg2;
    int lanev = lane;
    asm volatile("" : "+v"(lg2v), "+v"(lanev));
    const int l31v = lanev & 31, hhv = lanev >> 5;
    float kdec[8];
#pragma unroll
    for (int e8 = 0; e8 < 8; ++e8) {
      const int slot = (lanev & 7) * 8 + e8;
      const int orig = perm16(slot);
      kdec[e8] = fexp2(lg2v * (float)(dir == 0 ? 63 - orig : orig));
    }
    __syncthreads();
#pragma unroll
    for (int j = 0; j < 4; ++j) {
      rq[j] = ldg(Qg + (size_t)(r0 + 16 * j) * 128, qoff);
      rk[j] = ldg(Kg + (size_t)(r0 + 16 * j) * 128, qoff);
      rkt[j] = ldg(Ktg + (size_t)(32 * j) * MT + r0, toff);
      rv[j] = ldg(Vg + (size_t)(32 * j) * MT + r0, toff);
    }
#pragma unroll
    for (int j = 0; j < 4; ++j) {
      *(u32x4*)(sQ + (qrow + 16 * j) * 136 + qcol) = rq[j];
      *(u32x4*)(sK + (qrow + 16 * j) * 136 + qcol) = rk[j];
      *(u32x4*)(sV + (trow + 32 * j) * 72 + tcol) = rv[j];
      u32x4 u = rkt[j];
      u.x = pk2(bflo(u.x) * kdec[0], bfhi(u.x) * kdec[1]);
      u.y = pk2(bflo(u.y) * kdec[2], bfhi(u.y) * kdec[3]);
      u.z = pk2(bflo(u.z) * kdec[4], bfhi(u.z) * kdec[5]);
      u.w = pk2(bflo(u.w) * kdec[6], bfhi(u.w) * kdec[7]);
      *(u32x4*)(sKt + (trow + 32 * j) * 72 + tcol) = u;
    }
    __syncthreads();
#pragma unroll
    for (int qt = 0; qt < 2; ++qt) {
      f32x16 O;
#pragma unroll
      for (int r = 0; r < 16; ++r) O[r] = 0.f;
#pragma unroll
      for (int dkt = 0; dkt < 4; ++dkt)
#pragma unroll
        for (int tt = 0; tt < 2; ++tt) {
          const bf16x8 af = pack8(St[dkt][8 * tt], St[dkt][8 * tt + 1], St[dkt][8 * tt + 2], St[dkt][8 * tt + 3],
                                  St[dkt][8 * tt + 4], St[dkt][8 * tt + 5], St[dkt][8 * tt + 6], St[dkt][8 * tt + 7]);
          const bfraw* qp = sQ + (32 * qt + l31) * 136 + 32 * dkt + 16 * tt + 4 * hh;
          const u32x2 lo = *(const u32x2*)qp;
          const u32x2 hi = *(const u32x2*)(qp + 8);
          u32x4 u = {lo.x, lo.y, hi.x, hi.y};
          O = mfma(af, __builtin_bit_cast(bf16x8, u), O);
        }
      {
        const int offq = 32 * qt + l31v;
        const float qd = fexp2(lg2v * (float)(dir == 0 ? offq + 1 : 64 - offq));
#pragma unroll
        for (int r = 0; r < 16; ++r) O[r] *= qd;
      }
#pragma unroll
      for (int kt = 0; kt < 2; ++kt) {
        if (dir == 0 ? (kt <= qt) : (kt >= qt)) {
          f32x16 sc;
#pragma unroll
          for (int r = 0; r < 16; ++r) sc[r] = 0.f;
#pragma unroll
          for (int s = 0; s < 8; ++s) {
            const bf16x8 kf = *(const bf16x8*)(sK + (32 * kt + l31) * 136 + 16 * s + 8 * hh);
            const bf16x8 qf = *(const bf16x8*)(sQ + (32 * qt + l31) * 136 + 16 * s + 8 * hh);
            sc = mfma(kf, qf, sc);
          }
          const int offq = 32 * qt + l31v;
#pragma unroll
          for (int r = 0; r < 16; ++r) {
            const int offk = 32 * kt + 8 * (r >> 2) + 4 * hhv + (r & 3);
            const int dl = dir == 0 ? offq - offk : offk - offq;
            sc[r] = dl >= 0 ? sc[r] * fexp2(lg2v * (float)dl) : 0.f;
          }
#pragma unroll
          for (int tt = 0; tt < 2; ++tt) {
            const bf16x8 pf = pack8(sc[8 * tt], sc[8 * tt + 1], sc[8 * tt + 2], sc[8 * tt + 3],
                                    sc[8 * tt + 4], sc[8 * tt + 5], sc[8 * tt + 6], sc[8 * tt + 7]);
            const bf16x8 vf = *(const bf16x8*)(sV + (32 * w + l31) * 72 + 32 * kt + 16 * tt + 8 * hh);
            O = mfma(vf, pf, O);
          }
        }
      }
      float* op = og + (size_t)(r0 + 32 * qt + l31) * 1024 + head * 256 + half * 128 + 32 * w + 4 * hh;
#pragma unroll
      for (int g = 0; g < 4; ++g) {
        f32x4 v = {O[4 * g], O[4 * g + 1], O[4 * g + 2], O[4 * g + 3]};
        *(f32x4*)(op + 8 * g) = v;
      }
    }
#pragma unroll
    for (int d = 0; d < 4; ++d)
#pragma unroll
      for (int r = 0; r < 16; ++r) St[d][r] *= cd;
#pragma unroll
    for (int tt = 0; tt < 4; ++tt) {
      const bf16x8 vf = *(const bf16x8*)(sV + (32 * w + l31) * 72 + 16 * tt + 8 * hh);
#pragma unroll
      for (int dkt = 0; dkt < 4; ++dkt) {
        const bf16x8 kf = *(const bf16x8*)(sKt + (32 * dkt + l31) * 72 + 16 * tt + 8 * hh);
        St[dkt] = mfma(kf, vf, St[dkt]);
      }
    }
  }
  __syncthreads();
}

DEV int next_item(int* ctr, int* s_item) {
  __syncthreads();
  if (threadIdx.x == 0) *s_item = atomicAdd(ctr, 1);
  __syncthreads();
  return *s_item;
}

DEV void phase_attn_even(const Params& P, int layer, unsigned char* smem, int* s_item) {
  const int tid = otid(), lane = tid & 63, w = tid >> 6, l31 = lane & 31, hh = lane >> 5;
  bfraw* lds = (bfraw*)smem;
  const int e = layer >> 1;
  const float lambda_init = uni(0.8f - 0.6f * expf(-0.3f * (float)layer));
  float s01 = 0.f, s23 = 0.f;
  {
    const float* lp = P.diff_lambda + e * 256;
    for (int i = 0; i < 64; ++i) { s01 += lp[i] * lp[64 + i]; s23 += lp[128 + i] * lp[192 + i]; }
  }
  const float lam = uni(expf(s01) - expf(s23) + lambda_init);
  int* ctr = (int*)(P.ws + OFF_CTR) + layer;
  const int NCH = 16, NLAT = 8 * 128, NCX = 8 * 2;
  const int total = NCH + NLAT + NCX;
  int itq = next_item(ctr, s_item);
#ifndef NO_CHAIN
  while (itq < NCH) { chain_item(P, e, itq, lds); itq = next_item(ctr, s_item); }
#endif
  for (;; itq = next_item(ctr, s_item)) {
    if (itq >= total) break;
    int it = itq - NCH;
    int hd, q0, nk;
    if (it < NLAT) { hd = it >> 7; q0 = 256 + 128 * (it & 127); nk = MT; }
    else { it -= NLAT; hd = it >> 1; q0 = 128 * (it & 1); nk = 256; }
    f32x16 O[4];
    float l;
    float* tmp = (float*)(P.ws + OFF_DTMP) + ((size_t)blockIdx.x * 16 * 256 + tid) * 4;
    const bfraw* Vt = (const bfraw*)(P.ws + OFF_VTA) + (size_t)(hd * 128) * MT;
#pragma unroll 1
    for (int a = 0; a < 2; ++a) {
      const bfraw* Qh = (const bfraw*)(P.ws + OFF_QA) + (size_t)(2 * hd + a) * MT * 64;
      const bfraw* Kh = (const bfraw*)(P.ws + OFF_KA) + (size_t)(2 * hd + a) * MT * 64;
      flash_block<64>(Qh, Kh, Vt, q0, nk, lds, O, l);
      if (a == 0) {
        const float inv = 1.f / l;
#pragma unroll
        for (int d = 0; d < 4; ++d)
#pragma unroll
          for (int g = 0; g < 4; ++g) {
            f32x4 v = {O[d][4 * g] * inv, O[d][4 * g + 1] * inv, O[d][4 * g + 2] * inv, O[d][4 * g + 3] * inv};
            *(f32x4*)(tmp + (size_t)((d * 4 + g) * 256) * 4) = v;
          }
      }
    }
    const float c2 = lam / l;
    float ss = 0.f;
    f32x16 O1[4];
#pragma unroll
    for (int d = 0; d < 4; ++d)
#pragma unroll
      for (int g = 0; g < 4; ++g) {
        const f32x4 v = *(const f32x4*)(tmp + (size_t)((d * 4 + g) * 256) * 4);
        const float vv[4] = {v.x, v.y, v.z, v.w};
#pragma unroll
        for (int j = 0; j < 4; ++j) {
          const float o = vv[j] - c2 * O[d][4 * g + j];
          O1[d][4 * g + j] = o;
          ss += o * o;
        }
      }
    ss = xsum32(ss);
    const float rstd = rsqrtf(ss * (1.f / 128.f) + EPSN) * (1.f - lambda_init);
    const int m = q0 + 32 * w + l31;
    const bfraw* gp = (const bfraw*)(P.ws + OFF_GA) + (size_t)m * 1024 + hd * 128 + 4 * hh;
    bfraw* yp = (bfraw*)(P.ws + OFF_H) + (size_t)m * 2048 + hd * 128 + 4 * hh;
    const float* sg = P.diff_subln + e * 128 + 4 * hh;
#pragma unroll
    for (int d = 0; d < 4; ++d)
#pragma unroll
      for (int g = 0; g < 4; ++g) {
        const f32x4 s4 = *(const f32x4*)(sg + 32 * d + 8 * g);
        const u32x2 gg = *(const u32x2*)(gp + 32 * d + 8 * g);
        const float y0 = O1[d][4 * g] * rstd * s4.x * bflo(gg.x);
        const float y1 = O1[d][4 * g + 1] * rstd * s4.y * bfhi(gg.x);
        const float y2 = O1[d][4 * g + 2] * rstd * s4.z * bflo(gg.y);
        const float y3 = O1[d][4 * g + 3] * rstd * s4.w * bfhi(gg.y);
        u32x2 u = {pk2(y0, y1), pk2(y2, y3)};
        *(u32x2*)(yp + 32 * d + 8 * g) = u; __builtin_amdgcn_sched_barrier(0);
      }
  }
}

DEV void phase_attn_odd(const Params& P, int layer, unsigned char* smem, int* s_item) {
  const int tid = otid(), lane = tid & 63, w = tid >> 6, l31 = lane & 31, hh = lane >> 5;
  bfraw* lds = (bfraw*)smem;
  int* ctr = (int*)(P.ws + OFF_CTR) + layer;
  const int NLAT = 16 * 128, NCX = (layer < 3) ? 16 * 2 : 0;
  const int total = NLAT + NCX;
  for (;;) {
    int it = next_item(ctr, s_item);
    if (it >= total) break;
    int hq, q0, nk;
    if (it < NLAT) { hq = it >> 7; q0 = 256 + 128 * (it & 127); nk = MT; }
    else { it -= NLAT; hq = it >> 1; q0 = 128 * (it & 1); nk = 256; }
    const int kv = hq >> 2;
    f32x16 O[4];
    float l;
    flash_block<128>((const bfraw*)(P.ws + OFF_QC) + (size_t)hq * MT * 128, (const bfraw*)(P.ws + OFF_KC) + (size_t)kv * MT * 128,
                     (const bfraw*)(P.ws + OFF_VTC) + (size_t)(kv * 128) * MT, q0, nk, lds, O, l);
    const float inv = 1.f / l;
    const int m = q0 + 32 * w + l31;
    const bfraw* gp = (const bfraw*)(P.ws + OFF_GC) + (size_t)m * 2048 + hq * 128 + 4 * hh;
    bfraw* yp = (bfraw*)(P.ws + OFF_H) + (size_t)m * 2048 + hq * 128 + 4 * hh;
#pragma unroll
    for (int d = 0; d < 4; ++d)
#pragma unroll
      for (int g = 0; g < 4; ++g) {
        const u32x2 gg = *(const u32x2*)(gp + 32 * d + 8 * g);
        const float y0 = O[d][4 * g] * inv * bflo(gg.x);
        const float y1 = O[d][4 * g + 1] * inv * bfhi(gg.x);
        const float y2 = O[d][4 * g + 2] * inv * bflo(gg.y);
        const float y3 = O[d][4 * g + 3] * inv * bfhi(gg.y);
        u32x2 u = {pk2(y0, y1), pk2(y2, y3)};
        *(u32x2*)(yp + 32 * d + 8 * g) = u; __builtin_amdgcn_sched_barrier(0);
      }
  }
}

DEV void phase_comb(const Params& P, int e) {
  const int tid = otid(), lane = tid & 63, w = tid >> 6;
  const float* OFp = (const float*)(P.ws + OFF_OF);
  const float* OBp = (const float*)(P.ws + OFF_OB);
  const bfraw* GB = (const bfraw*)(P.ws + OFF_GB);
  bfraw* Y = (bfraw*)(P.ws + OFF_H);
  for (int idx = blockIdx.x * 4 + w; idx < MT * 4; idx += gridDim.x * 4) {
    const int m = idx >> 2, head = idx & 3;
    const size_t o = (size_t)m * 1024 + head * 256 + lane * 4;
    const f32x4 a = *(const f32x4*)(OFp + o);
    const f32x4 b = *(const f32x4*)(OBp + o);
    float z0 = a.x + b.x, z1 = a.y + b.y, z2 = a.z + b.z, z3 = a.w + b.w;
    const float mu = wave_sum(z0 + z1 + z2 + z3, lane) * (1.f / 256.f);
    z0 -= mu; z1 -= mu; z2 -= mu; z3 -= mu;
    const float var = wave_sum(z0 * z0 + z1 * z1 + z2 * z2 + z3 * z3, lane) * (1.f / 256.f);
    const float rstd = rsqrtf(var + EPSN);
    const f32x4 g4 = *(const f32x4*)(P.ret_gn + e * 1024 + head * 256 + lane * 4);
    const u32x2 gg = *(const u32x2*)(GB + o);
    u32x2 u = {pk2(z0 * rstd * g4.x * bflo(gg.x), z1 * rstd * g4.y * bfhi(gg.x)),
               pk2(z2 * rstd * g4.z * bflo(gg.y), z3 * rstd * g4.w * bfhi(gg.y))};
    *(u32x2*)(Y + (size_t)m * 2048 + 1024 + head * 256 + lane * 4) = u;
  }
}

__global__ void __launch_bounds__(256, 2) mega(Params P) {
  cg::grid_group grid = cg::this_grid();
  __shared__ __attribute__((aligned(16))) unsigned char smem[73728];
  __shared__ int s_item;
  phase0(P, smem);
  grid.sync();
  phase0b(P);
  grid.sync();
#pragma unroll 1
  for (int layer = 0; layer < 4; ++layer) {
    phase_norm(P, layer);
    grid.sync();
    phase_gemm(P, layer, layer & 1, smem);
    grid.sync();
    if (layer & 1) {
      phase_attn_odd(P, layer, smem, &s_item);
    } else {
      phase_attn_even(P, layer, smem, &s_item);
      grid.sync();
      phase_comb(P, layer >> 1);
    }
    grid.sync();
    phase_gemm(P, layer, 2, smem);
    grid.sync();
  }
  phase_final(P);
}

extern "C" void kernel_launch(void* const* d_in, const int* in_sizes, int n_in, void* d_out, int out_size, void* d_ws,
                              size_t ws_size, hipStream_t stream) {
  static int grid_blocks = 0;
  if (grid_blocks == 0) {
    if (n_in != 17 || ws_size < WS_END) {
      fprintf(stderr, "kernel_launch: need 17 inputs and >= %zu bytes of workspace; got %d inputs, %zu bytes\n", (size_t)WS_END, n_in, ws_size);
      grid_blocks = -1;
      return;
    }
    int dev = 0, cus = 0, per_cu = 0;
    hipGetDevice(&dev);
    hipDeviceGetAttribute(&cus, hipDeviceAttributeMultiprocessorCount, dev);
    hipOccupancyMaxActiveBlocksPerMultiprocessor(&per_cu, (const void*)mega, 256, 0);
    if (per_cu > 2) per_cu = 2;
    if (per_cu < 1) per_cu = 1;
    grid_blocks = cus * per_cu;
  }
  if (grid_blocks < 0) return;
  Params p{};
  p.x = (const float*)d_in[0]; p.c = (const float*)d_in[1]; p.ctx = (const float*)d_in[2]; p.c_ctx = (const float*)d_in[3];
  p.norm_g = (const float*)d_in[4]; p.w_mod = (const float*)d_in[5]; p.b_mod = (const float*)d_in[6];
  p.ev_w_in = (const float*)d_in[7]; p.ev_w_out = (const float*)d_in[8]; p.diff_lambda = (const float*)d_in[9];
  p.diff_subln = (const float*)d_in[10]; p.ret_decay = (const float*)d_in[11]; p.ret_gn = (const float*)d_in[12];
  p.od_w_in = (const float*)d_in[13]; p.od_w_out = (const float*)d_in[14]; p.qk_norm = (const float*)d_in[15];
  p.final_norm = (const float*)d_in[16];
  p.out = (float*)d_out; p.ws = (unsigned char*)d_ws;
  void* args[] = {&p};
  hipError_t e = hipLaunchCooperativeKernel((const void*)mega, dim3(grid_blocks), dim3(256), args, 0, stream);
  if (e != hipSuccess) fprintf(stderr, "cooperative launch failed: %s (grid %d)\n", hipGetErrorString(e), grid_blocks);
}
```

```cpp
#include <hip/hip_runtime.h>
#include <hip/hip_cooperative_groups.h>
#include <cstdio>
namespace cg = cooperative_groups;
#ifndef PROBE_DUP
#define PROBE_DUP 0
#endif

typedef unsigned short bfraw;
typedef __attribute__((ext_vector_type(8))) __bf16 bf16x8;
typedef __attribute__((ext_vector_type(2))) __bf16 bf16x2;
typedef __attribute__((ext_vector_type(2))) float f32x2;
typedef __attribute__((ext_vector_type(16))) float f32x16;
typedef __attribute__((ext_vector_type(4))) float f32x4;
typedef __attribute__((ext_vector_type(4))) unsigned u32x4;
typedef __attribute__((ext_vector_type(2))) unsigned u32x2;

#define DEV static __device__ __forceinline__

constexpr int MT = 16640;
constexpr int DM = 2048;
constexpr float LOG2E = 1.4426950408889634f;
constexpr float EPSN = 1e-6f;

constexpr size_t OFF_WT_EVIN  = 0;
constexpr size_t OFF_WT_EVOUT = OFF_WT_EVIN + (size_t)2 * 7168 * 2048 * 2;
constexpr size_t OFF_WT_ODIN  = OFF_WT_EVOUT + (size_t)2 * 2048 * 2048 * 2;
constexpr size_t OFF_WT_ODOUT = OFF_WT_ODIN + (size_t)2 * 5120 * 2048 * 2;
constexpr size_t OFF_MODPART  = OFF_WT_ODOUT + (size_t)2 * 2048 * 2048 * 2;
constexpr size_t OFF_MODV     = OFF_MODPART + (size_t)16 * 4 * 2 * 6144 * 4;
constexpr size_t OFF_ROPE     = OFF_MODV + (size_t)4 * 2 * 6144 * 4;
constexpr size_t OFF_CTR      = OFF_ROPE + (size_t)(8192 + 16384) * 4;
constexpr size_t OFF_CTXRES   = OFF_CTR + 256;
constexpr size_t OFF_H        = OFF_CTXRES + (size_t)256 * 2048 * 4;
constexpr size_t OFF_PROJ     = OFF_H + (size_t)MT * 2048 * 2;
constexpr size_t SZ_A         = (size_t)MT * 1024 * 2;
constexpr size_t SZ_B         = (size_t)MT * 512 * 2;
constexpr size_t OFF_QA  = OFF_PROJ;
constexpr size_t OFF_KA  = OFF_QA + SZ_A;
constexpr size_t OFF_VTA = OFF_KA + SZ_A;
constexpr size_t OFF_GA  = OFF_VTA + SZ_A;
constexpr size_t OFF_QB  = OFF_GA + SZ_A;
constexpr size_t OFF_KB  = OFF_QB + SZ_B;
constexpr size_t OFF_KBT = OFF_KB + SZ_B;
constexpr size_t OFF_VTB = OFF_KBT + SZ_B;
constexpr size_t OFF_GB  = OFF_VTB + SZ_A;
constexpr size_t OFF_PROJ_END = OFF_GB + SZ_A;
constexpr size_t OFF_QC  = OFF_PROJ;
constexpr size_t OFF_KC  = OFF_QC + 2 * SZ_A;
constexpr size_t OFF_VTC = OFF_KC + SZ_B;
constexpr size_t OFF_GC  = OFF_VTC + SZ_B;
constexpr size_t OFF_OF  = OFF_PROJ_END;
constexpr size_t OFF_OB  = OFF_OF + (size_t)MT * 1024 * 4;
constexpr size_t OFF_DTMP = OFF_OB + (size_t)MT * 1024 * 4;
constexpr size_t WS_END  = OFF_DTMP + (size_t)1024 * 256 * 64 * 4;

struct Params {
  const float *x, *c, *ctx, *c_ctx, *norm_g, *w_mod, *b_mod, *ev_w_in, *ev_w_out, *diff_lambda, *diff_subln,
      *ret_decay, *ret_gn, *od_w_in, *od_w_out, *qk_norm, *final_norm;
  float* out;
  unsigned char* ws;
};

DEV f32x16 mfma(bf16x8 a, bf16x8 b, f32x16 c) { return __builtin_amdgcn_mfma_f32_32x32x16_bf16(a, b, c, 0, 0, 0); }
DEV unsigned pk2(float a, float b) {
  f32x2 v = {a, b};
  bf16x2 r = __builtin_convertvector(v, bf16x2);
  return __builtin_bit_cast(unsigned, r);
}
DEV u32x4 ldg(const bfraw* ubase, unsigned voff) { return *(const u32x4*)((const char*)ubase + voff); }
DEV int otid() {
  const int wv = __builtin_amdgcn_readfirstlane((int)threadIdx.x >> 6);
  int t = wv * 64 + (int)__builtin_amdgcn_mbcnt_hi(~0u, __builtin_amdgcn_mbcnt_lo(~0u, 0u));
  asm volatile("" : "+v"(t));
  return t;
}
DEV float bflo(unsigned u) { return __uint_as_float(u << 16); }
DEV float bfhi(unsigned u) { return __uint_as_float(u & 0xffff0000u); }
DEV bf16x8 pack8(float a0, float a1, float a2, float a3, float a4, float a5, float a6, float a7) {
  u32x4 u = {pk2(a0, a1), pk2(a2, a3), pk2(a4, a5), pk2(a6, a7)};
  return __builtin_bit_cast(bf16x8, u);
}
DEV bfraw f2bf(float a) { return (bfraw)(pk2(a, 0.f) & 0xffffu); }
DEV float fexp2(float x) { return __builtin_amdgcn_exp2f(x); }
DEV float wave_sum(float v, int lane) {
#pragma unroll
  for (int o = 1; o < 64; o <<= 1) v += __int_as_float(__builtin_amdgcn_ds_bpermute((lane ^ o) << 2, __float_as_int(v)));
  return v;
}
DEV float xsum32(float x) {
  const u32x2 r = __builtin_amdgcn_permlane32_swap(__float_as_uint(x), __float_as_uint(x), false, false);
  return __uint_as_float(r.x) + __uint_as_float(r.y);
}
DEV float xmax32(float x) {
  const u32x2 r = __builtin_amdgcn_permlane32_swap(__float_as_uint(x), __float_as_uint(x), false, false);
  return fmaxf(__uint_as_float(r.x), __uint_as_float(r.y));
}
DEV float uni(float x) { return __int_as_float(__builtin_amdgcn_readfirstlane(__float_as_int(x))); }
DEV float siluf(float v) { return v / (1.f + __expf(-v)); }
DEV int perm16(int m) {
  int b = (m >> 2) & 3;
  int b2 = ((b & 1) << 1) | (b >> 1);
  return (m & ~12) | (b2 << 2);
}

DEV const float* res_src(const Params& P, int layer, int row) {
  if (row < 256) return (layer == 0 ? P.ctx : (const float*)(P.ws + OFF_CTXRES)) + (size_t)row * DM;
  return (layer == 0 ? P.x : (const float*)P.out) + (size_t)(row - 256) * DM;
}
DEV float* res_dst(const Params& P, int row) {
  if (row < 256) return (float*)(P.ws + OFF_CTXRES) + (size_t)row * DM;
  return P.out + (size_t)(row - 256) * DM;
}

DEV void phase0(const Params& P, unsigned char* smem) {
  const int tid = otid();
  const int gtid = blockIdx.x * 256 + tid, gsz = gridDim.x * 256;
  if (gtid < 16) ((int*)(P.ws + OFF_CTR))[gtid] = 0;
  float* rope = (float*)(P.ws + OFF_ROPE);
  for (int i = gtid; i < 4096 + 8192; i += gsz) {
    int pos, f; float inv; float *pc, *ps;
    if (i < 4096) { pos = i >> 4; f = i & 15; inv = exp2f(-(float)f * (13.287712379549449f / 16.f)); pc = rope + i; ps = rope + 4096 + i; }
    else { int j = i - 4096; pos = j >> 5; f = j & 31; inv = exp2f(-(float)f * (13.287712379549449f / 32.f)); pc = rope + 8192 + j; ps = rope + 16384 + j; }
    float ang = (float)pos * inv;
    double a = (double)ang;
    double kk = rint(a * 0.15915494309189535);
    float r = (float)(a - kk * 6.283185307179586);
    *pc = __cosf(r); *ps = __sinf(r);
  }
  const int NG = 4 * 16 * 6, NTT = 16384;
  for (int it = blockIdx.x; it < NG + NTT; it += gridDim.x) {
    if (it < NG) {
      const int layer = it / 96, rem = it % 96, kc = rem / 6, ng = rem % 6;
      const int n = ng * 1024 + tid * 4;
      const float* W = P.w_mod + ((size_t)layer * 2048 + kc * 128) * 6144 + n;
      f32x4 al = {0.f, 0.f, 0.f, 0.f}, ac = {0.f, 0.f, 0.f, 0.f};
#pragma unroll 8
      for (int k = 0; k < 128; ++k) {
        const float cl = P.c[kc * 128 + k], cc = P.c_ctx[kc * 128 + k];
        const float sl = siluf(cl), sx = siluf(cc);
        const f32x4 w4 = *(const f32x4*)(W + (size_t)k * 6144);
        al.x += sl * w4.x; al.y += sl * w4.y; al.z += sl * w4.z; al.w += sl * w4.w;
        ac.x += sx * w4.x; ac.y += sx * w4.y; ac.z += sx * w4.z; ac.w += sx * w4.w;
      }
      float* part = (float*)(P.ws + OFF_MODPART) + ((size_t)(kc * 4 + layer) * 2) * 6144;
      *(f32x4*)(part + n) = al;
      *(f32x4*)(part + 6144 + n) = ac;
    } else {
      int t = it - NG;
      const float* src; bfraw* dst; int N;
      if (t < 7168) { int l = t / 3584; t -= l * 3584; N = 7168; src = P.ev_w_in + (size_t)l * 2048 * 7168; dst = (bfraw*)(P.ws + OFF_WT_EVIN) + (size_t)l * 7168 * 2048; }
      else if (t < 7168 + 2048) { t -= 7168; int l = t / 1024; t -= l * 1024; N = 2048; src = P.ev_w_out + (size_t)l * 2048 * 2048; dst = (bfraw*)(P.ws + OFF_WT_EVOUT) + (size_t)l * 2048 * 2048; }
      else if (t < 7168 + 2048 + 5120) { t -= 9216; int l = t / 2560; t -= l * 2560; N = 5120; src = P.od_w_in + (size_t)l * 2048 * 5120; dst = (bfraw*)(P.ws + OFF_WT_ODIN) + (size_t)l * 5120 * 2048; }
      else { t -= 14336; int l = t / 1024; t -= l * 1024; N = 2048; src = P.od_w_out + (size_t)l * 2048 * 2048; dst = (bfraw*)(P.ws + OFF_WT_ODOUT) + (size_t)l * 2048 * 2048; }
      const int ntn = N >> 6;
      const int ntile = t % ntn, ktile = t / ntn;
      float* sT = (float*)smem;
#pragma unroll
      for (int j = 0; j < 4; ++j) {
        const int idx = tid + 256 * j, krow = idx >> 4, c4 = idx & 15;
        const f32x4 v = *(const f32x4*)(src + (size_t)(ktile * 64 + krow) * N + ntile * 64 + c4 * 4);
        float* d = sT + krow * 65 + c4 * 4;
        d[0] = v.x; d[1] = v.y; d[2] = v.z; d[3] = v.w;
      }
      __syncthreads();
#pragma unroll
      for (int j = 0; j < 2; ++j) {
        const int idx = tid + 256 * j, kg = idx & 7, n = idx >> 3;
        const float* s = sT + (kg * 8) * 65 + n;
        u32x4 u = {pk2(s[0], s[65]), pk2(s[130], s[195]), pk2(s[260], s[325]), pk2(s[390], s[455])};
        *(u32x4*)(dst + (size_t)(ntile * 64 + n) * 2048 + ktile * 64 + kg * 8) = u;
      }
      __syncthreads();
    }
  }
}

DEV void phase0b(const Params& P) {
  const int gtid = blockIdx.x * 256 + otid(), gsz = gridDim.x * 256;
  const float* part = (const float*)(P.ws + OFF_MODPART);
  float* modv = (float*)(P.ws + OFF_MODV);
  for (int i = gtid; i < 4 * 2 * 6144; i += gsz) {
    const int layer = i / 12288, rem = i % 12288, which = rem / 6144, n = rem % 6144;
    float s = P.b_mod[layer * 6144 + n];
#pragma unroll
    for (int kc = 0; kc < 16; ++kc) s += part[((size_t)(kc * 4 + layer) * 2 + which) * 6144 + n];
    modv[i] = s;
  }
}

DEV void phase_norm(const Params& P, int layer) {
  const int tid = otid(), lane = tid & 63, w = tid >> 6;
  const float* g = P.norm_g + layer * 2048;
  const float* modv = (const float*)(P.ws + OFF_MODV) + (size_t)layer * 2 * 6144;
  bfraw* H = (bfraw*)(P.ws + OFF_H);
  for (int row = blockIdx.x * 4 + w; row < MT; row += gridDim.x * 4) {
    const float* src = res_src(P, layer, row);
    const float* mv = modv + (row < 256 ? 6144 : 0);
    f32x4 v[8];
    float ss = 0.f;
#pragma unroll
    for (int it = 0; it < 8; ++it) {
      v[it] = *(const f32x4*)(src + (it * 64 + lane) * 4);
      ss += v[it].x * v[it].x + v[it].y * v[it].y + v[it].z * v[it].z + v[it].w * v[it].w;
    }
    ss = wave_sum(ss, lane);
    const float rstd = rsqrtf(ss * (1.f / 2048.f) + EPSN);
#pragma unroll
    for (int it = 0; it < 8; ++it) {
      const int c = (it * 64 + lane) * 4;
      const f32x4 g4 = *(const f32x4*)(g + c);
      const f32x4 sh = *(const f32x4*)(mv + c);
      const f32x4 sc = *(const f32x4*)(mv + 2048 + c);
      const float y0 = v[it].x * rstd * g4.x * (1.f + sc.x) + sh.x;
      const float y1 = v[it].y * rstd * g4.y * (1.f + sc.y) + sh.y;
      const float y2 = v[it].z * rstd * g4.z * (1.f + sc.z) + sh.z;
      const float y3 = v[it].w * rstd * g4.w * (1.f + sc.w) + sh.w;
      u32x2 u = {pk2(y0, y1), pk2(y2, y3)};
      *(u32x2*)(H + (size_t)row * 2048 + c) = u;
    }
  }
}

DEV void phase_final(const Params& P) {
  const int tid = otid(), lane = tid & 63, w = tid >> 6;
  for (int row = blockIdx.x * 4 + w; row < 16384; row += gridDim.x * 4) {
    float* src = P.out + (size_t)row * DM;
    f32x4 v[8];
    float ss = 0.f;
#pragma unroll
    for (int it = 0; it < 8; ++it) {
      v[it] = *(const f32x4*)(src + (it * 64 + lane) * 4);
      ss += v[it].x * v[it].x + v[it].y * v[it].y + v[it].z * v[it].z + v[it].w * v[it].w;
    }
    ss = wave_sum(ss, lane);
    const float rstd = rsqrtf(ss * (1.f / 2048.f) + EPSN);
#pragma unroll
    for (int it = 0; it < 8; ++it) {
      const int c = (it * 64 + lane) * 4;
      const f32x4 g4 = *(const f32x4*)(P.final_norm + c);
      f32x4 y = {v[it].x * rstd * g4.x, v[it].y * rstd * g4.y, v[it].z * rstd * g4.z, v[it].w * rstd * g4.w};
      *(f32x4*)(src + c) = y;
    }
  }
}

template <bool FEAT>
DEV void gemm_main(const bfraw* A, const bfraw* W, int m0, int n0, bfraw* lds, f32x16 (&acc)[4]) {
  const int tid = otid(), lane = tid & 63, w = tid >> 6, l31 = lane & 31, hh = lane >> 5;
  const int srow = tid >> 3, scol = (tid & 7) * 8;
  const bfraw* ap = A + (size_t)m0 * 2048;
  const bfraw* wp = W + (size_t)n0 * 2048;
  const unsigned goff = (unsigned)(srow * 2048 + scol) * 2u;
  u32x4 ra[4], rw[4];
#pragma unroll
  for (int j = 0; j < 4; ++j) {
    ra[j] = ldg(ap + (size_t)j * 32 * 2048, goff);
    rw[j] = ldg(wp + (size_t)j * 32 * 2048, goff);
  }
#pragma unroll
  for (int nt = 0; nt < 4; ++nt)
#pragma unroll
    for (int r = 0; r < 16; ++r) acc[nt][r] = 0.f;
#pragma unroll
  for (int j = 0; j < 4; ++j) {
    *(u32x4*)(lds + (srow + 32 * j) * 72 + scol) = ra[j];
    *(u32x4*)(lds + 9216 + (srow + 32 * j) * 72 + scol) = rw[j];
  }
  __syncthreads();
#pragma unroll 1
  for (int kt = 0; kt < 32; ++kt) {
    const bfraw* cA = lds + (kt & 1) * 18432;
    const bfraw* cB = cA + 9216;
    if (kt + 1 < 32) {
#pragma unroll
      for (int j = 0; j < 4; ++j) {
        ra[j] = ldg(ap + (size_t)j * 32 * 2048 + (kt + 1) * 64, goff);
        rw[j] = ldg(wp + (size_t)j * 32 * 2048 + (kt + 1) * 64, goff);
      }
    }
#pragma unroll
    for (int s = 0; s < 4; ++s) {
      const bf16x8 fm = *(const bf16x8*)(cA + (32 * w + l31) * 72 + s * 16 + hh * 8);
#pragma unroll
      for (int nt = 0; nt < 4; ++nt) {
        const bf16x8 fn = *(const bf16x8*)(cB + (32 * nt + l31) * 72 + s * 16 + hh * 8);
        if (FEAT) acc[nt] = mfma(fm, fn, acc[nt]);
        else acc[nt] = mfma(fn, fm, acc[nt]);
      }
    }
    if (kt + 1 < 32) {
      bfraw* nA = lds + ((kt + 1) & 1) * 18432;
#pragma unroll
      for (int j = 0; j < 4; ++j) {
        *(u32x4*)(nA + (srow + 32 * j) * 72 + scol) = ra[j];
        *(u32x4*)(nA + 9216 + (srow + 32 * j) * 72 + scol) = rw[j];
      }
    }
    __syncthreads();
  }
}

DEV void phase_gemm(const Params& P, int layer, int kind, unsigned char* smem) {
  const int tid = otid(), lane = tid & 63, w = tid >> 6, l31 = lane & 31, hh = lane >> 5;
  bfraw* lds = (bfraw*)smem;
  const int eo = layer >> 1;
  const bfraw* A = (const bfraw*)(P.ws + OFF_H);
  const bfraw* W;
  int NTN, mt0 = 0;
  if (kind == 0) { W = (const bfraw*)(P.ws + OFF_WT_EVIN) + (size_t)eo * 7168 * 2048; NTN = 56; }
  else if (kind == 1) { W = (const bfraw*)(P.ws + OFF_WT_ODIN) + (size_t)eo * 5120 * 2048; NTN = 40; }
  else { W = (const bfraw*)(P.ws + ((layer & 1) ? OFF_WT_ODOUT : OFF_WT_EVOUT)) + (size_t)eo * 2048 * 2048; NTN = 16; if (layer == 3) mt0 = 2; }
  const float* rope = (const float*)(P.ws + OFF_ROPE);
  const int ntiles = (130 - mt0) * NTN;
  for (int t = blockIdx.x; t < ntiles; t += gridDim.x) {
    const int mt = mt0 + t / NTN, tn = t % NTN;
    const int m0 = mt * 128, n0 = tn * 128;
    f32x16 acc[4];
    int vcol = -1; bfraw* vdst = nullptr;
    if (kind == 0) {
      if (tn >= 16 && tn < 24) { vcol = (tn - 16) * 128; vdst = (bfraw*)(P.ws + OFF_VTA); }
      else if (tn >= 40 && tn < 48) { vcol = (tn - 40) * 128; vdst = (bfraw*)(P.ws + OFF_VTB); }
    } else if (kind == 1) {
      if (tn >= 20 && tn < 24) { vcol = (tn - 20) * 128; vdst = (bfraw*)(P.ws + OFF_VTC); }
    }
    if (vcol >= 0) {
      gemm_main<true>(A, W, m0, n0, lds, acc);
#pragma unroll
      for (int nt = 0; nt < 4; ++nt) {
        bfraw* rowp = vdst + (size_t)(vcol + 32 * nt + l31) * MT;
#pragma unroll
        for (int g = 0; g < 4; ++g) {
          const int pos = m0 + 32 * w + 16 * (g >> 1) + 8 * hh + 4 * (g & 1);
          u32x2 u = {pk2(acc[nt][4 * g], acc[nt][4 * g + 1]), pk2(acc[nt][4 * g + 2], acc[nt][4 * g + 3])};
          *(u32x2*)(rowp + pos) = u; __builtin_amdgcn_sched_barrier(0);
        }
      }
      continue;
    }
    gemm_main<false>(A, W, m0, n0, lds, acc);
    const int m = m0 + 32 * w + l31;
    const bool lat = m0 >= 256;
    const int tl = m - 256;
    const int prow = (tl >> 6) & 255, pcol = tl & 63;
    if (kind == 2) {
      const float* gate = (const float*)(P.ws + OFF_MODV) + ((size_t)layer * 2 + (lat ? 0 : 1)) * 6144 + 4096;
      const float* srow_ = res_src(P, layer, m);
      float* drow = res_dst(P, m);
#pragma unroll
      for (int nt = 0; nt < 4; ++nt)
#pragma unroll
        for (int g = 0; g < 4; ++g) {
          const int n = n0 + 32 * nt + 8 * g + 4 * hh;
          f32x4 xo = *(const f32x4*)(srow_ + n);
          const f32x4 gt = *(const f32x4*)(gate + n);
          xo.x += gt.x * acc[nt][4 * g]; xo.y += gt.y * acc[nt][4 * g + 1];
          xo.z += gt.z * acc[nt][4 * g + 2]; xo.w += gt.w * acc[nt][4 * g + 3];
          *(f32x4*)(drow + n) = xo; __builtin_amdgcn_sched_barrier(0);
        }
      continue;
    }
    if (kind == 0) {
      if (tn < 16) {
        const bool isq = tn < 8;
        const int hb = 2 * (isq ? tn : tn - 8);
        bfraw* dst = (bfraw*)(P.ws + (isq ? OFF_QA : OFF_KA));
        const float scl = isq ? 0.125f * LOG2E : 1.f;
        if (lat) {
#pragma unroll
          for (int nt = 0; nt < 4; ++nt) {
            const int pos = (nt & 1) ? pcol : prow;
#pragma unroll
            for (int g = 0; g < 2; ++g) {
              const f32x4 c4 = *(const f32x4*)(rope + pos * 16 + 8 * g + 4 * hh);
              const f32x4 s4 = *(const f32x4*)(rope + 4096 + pos * 16 + 8 * g + 4 * hh);
              const float cc[4] = {c4.x, c4.y, c4.z, c4.w}, sn[4] = {s4.x, s4.y, s4.z, s4.w};
#pragma unroll
              for (int j = 0; j < 4; ++j) {
                const float x1 = acc[nt][4 * g + j], x2 = acc[nt][4 * g + j + 8];
                acc[nt][4 * g + j] = x1 * cc[j] - x2 * sn[j];
                acc[nt][4 * g + j + 8] = x1 * sn[j] + x2 * cc[j];
              }
              __builtin_amdgcn_sched_barrier(0);
            }
          }
        }
#pragma unroll
        for (int nt = 0; nt < 4; ++nt) {
          bfraw* rp = dst + ((size_t)(hb + (nt >> 1)) * MT + m) * 64 + (nt & 1) * 32 + 4 * hh;
#pragma unroll
          for (int g = 0; g < 4; ++g) {
            u32x2 u = {pk2(acc[nt][4 * g] * scl, acc[nt][4 * g + 1] * scl), pk2(acc[nt][4 * g + 2] * scl, acc[nt][4 * g + 3] * scl)};
            *(u32x2*)(rp + 8 * g) = u; __builtin_amdgcn_sched_barrier(0);
          }
        }
      } else if (tn < 32 || tn >= 48) {
        bfraw* dst = (tn < 32) ? (bfraw*)(P.ws + OFF_GA) + (size_t)m * 1024 + (tn - 24) * 128
                               : (bfraw*)(P.ws + OFF_GB) + (size_t)m * 1024 + (tn - 48) * 128;
#pragma unroll
        for (int nt = 0; nt < 4; ++nt)
#pragma unroll
          for (int g = 0; g < 4; ++g) {
            u32x2 u = {pk2(siluf(acc[nt][4 * g]), siluf(acc[nt][4 * g + 1])), pk2(siluf(acc[nt][4 * g + 2]), siluf(acc[nt][4 * g + 3]))};
            *(u32x2*)(dst + 32 * nt + 8 * g + 4 * hh) = u; __builtin_amdgcn_sched_barrier(0);
          }
      } else if (tn < 36) {
        bfraw* rp = (bfraw*)(P.ws + OFF_QB) + ((size_t)(tn - 32) * MT + m) * 128 + 4 * hh;
#pragma unroll
        for (int nt = 0; nt < 4; ++nt)
#pragma unroll
          for (int g = 0; g < 4; ++g) {
            u32x2 u = {pk2(acc[nt][4 * g], acc[nt][4 * g + 1]), pk2(acc[nt][4 * g + 2], acc[nt][4 * g + 3])};
            *(u32x2*)(rp + 32 * nt + 8 * g) = u; __builtin_amdgcn_sched_barrier(0);
          }
      } else {
        const int head = tn - 36;
        const float scl = 0.08838834764831845f;
        bfraw* rp = (bfraw*)(P.ws + OFF_KB) + ((size_t)head * MT + m) * 128 + 4 * hh;
        bfraw* tp = (bfraw*)(P.ws + OFF_KBT) + (size_t)(head * 128) * MT + perm16(m);
#pragma unroll
        for (int nt = 0; nt < 4; ++nt)
#pragma unroll
          for (int g = 0; g < 4; ++g) {
            const unsigned u0 = pk2(acc[nt][4 * g] * scl, acc[nt][4 * g + 1] * scl);
            const unsigned u1 = pk2(acc[nt][4 * g + 2] * scl, acc[nt][4 * g + 3] * scl);
            u32x2 u = {u0, u1};
            *(u32x2*)(rp + 32 * nt + 8 * g) = u; __builtin_amdgcn_sched_barrier(0);
            const int nl = 32 * nt + 8 * g + 4 * hh;
            tp[(size_t)(nl + 0) * MT] = (bfraw)(u0 & 0xffffu);
            tp[(size_t)(nl + 1) * MT] = (bfraw)(u0 >> 16);
            tp[(size_t)(nl + 2) * MT] = (bfraw)(u1 & 0xffffu);
            tp[(size_t)(nl + 3) * MT] = (bfraw)(u1 >> 16); __builtin_amdgcn_sched_barrier(0);
          }
      }
    } else {
      if (tn < 20) {
        const bool isq = tn < 16;
        const int head = isq ? tn : tn - 16;
        const float* qg = P.qk_norm + eo * 256 + (isq ? 0 : 128);
        bfraw* rp = (bfraw*)(P.ws + (isq ? OFF_QC : OFF_KC)) + ((size_t)head * MT + m) * 128 + 4 * hh;
        const float scl = isq ? 0.08838834764831845f * LOG2E : 1.f;
        float ss = 0.f;
#pragma unroll
        for (int nt = 0; nt < 4; ++nt)
#pragma unroll
          for (int r = 0; r < 16; ++r) ss += acc[nt][r] * acc[nt][r];
        ss = xsum32(ss);
        const float rstd = rsqrtf(ss * (1.f / 128.f) + EPSN);
#pragma unroll
        for (int nt = 0; nt < 4; ++nt)
#pragma unroll
          for (int g = 0; g < 4; ++g) {
            const f32x4 g4 = *(const f32x4*)(qg + 32 * nt + 8 * g + 4 * hh);
            acc[nt][4 * g] *= rstd * g4.x; acc[nt][4 * g + 1] *= rstd * g4.y;
            acc[nt][4 * g + 2] *= rstd * g4.z; acc[nt][4 * g + 3] *= rstd * g4.w; __builtin_amdgcn_sched_barrier(0);
          }
        if (lat) {
#pragma unroll
          for (int p = 0; p < 2; ++p) {
            const int pos = p ? pcol : prow;
#pragma unroll
            for (int g = 0; g < 4; ++g) {
              const f32x4 c4 = *(const f32x4*)(rope + 8192 + pos * 32 + 8 * g + 4 * hh);
              const f32x4 s4 = *(const f32x4*)(rope + 16384 + pos * 32 + 8 * g + 4 * hh);
              const float cc[4] = {c4.x, c4.y, c4.z, c4.w}, sn[4] = {s4.x, s4.y, s4.z, s4.w};
#pragma unroll
              for (int j = 0; j < 4; ++j) {
                const float x1 = acc[2 * p][4 * g + j], x2 = acc[2 * p + 1][4 * g + j];
                acc[2 * p][4 * g + j] = x1 * cc[j] - x2 * sn[j];
                acc[2 * p + 1][4 * g + j] = x1 * sn[j] + x2 * cc[j];
              }
              __builtin_amdgcn_sched_barrier(0);
            }
          }
        }
#pragma unroll
        for (int nt = 0; nt < 4; ++nt)
#pragma unroll
          for (int g = 0; g < 4; ++g) {
            u32x2 u = {pk2(acc[nt][4 * g] * scl, acc[nt][4 * g + 1] * scl), pk2(acc[nt][4 * g + 2] * scl, acc[nt][4 * g + 3] * scl)};
            *(u32x2*)(rp + 32 * nt + 8 * g) = u; __builtin_amdgcn_sched_barrier(0);
          }
      } else {
        bfraw* dst = (bfraw*)(P.ws + OFF_GC) + (size_t)m * 2048 + (tn - 24) * 128;
#pragma unroll
        for (int nt = 0; nt < 4; ++nt)
#pragma unroll
          for (int g = 0; g < 4; ++g) {
            u32x2 u = {pk2(siluf(acc[nt][4 * g]), siluf(acc[nt][4 * g + 1])), pk2(siluf(acc[nt][4 * g + 2]), siluf(acc[nt][4 * g + 3]))};
            *(u32x2*)(dst + 32 * nt + 8 * g + 4 * hh) = u; __builtin_amdgcn_sched_barrier(0);
          }
      }
    }
  }
}

template <int D>
DEV void flash_block(const bfraw* Qh, const bfraw* Kh, const bfraw* Vt, int q0, int nk, bfraw* lds, f32x16 (&O)[4], float& lsum) {
  constexpr int KS = D + 8;
  constexpr int KT = 64 * KS;
  constexpr int STG = KT + 128 * 72;
  constexpr int KCH = D / 8;
  constexpr int NKC = 64 * KCH / 256;
  const int tid = otid(), lane = tid & 63, w = tid >> 6, l31 = lane & 31, hh = lane >> 5;
  bf16x8 qf[D / 16];
  {
    const bfraw* qp = Qh + (size_t)(q0 + 32 * w + l31) * D + 8 * hh;
#pragma unroll
    for (int s = 0; s < D / 16; ++s) qf[s] = *(const bf16x8*)(qp + 16 * s);
  }
#pragma unroll
  for (int d = 0; d < 4; ++d)
#pragma unroll
    for (int r = 0; r < 16; ++r) O[d][r] = 0.f;
  lsum = 0.f;
  u32x4 rk[NKC], rv[4];
  const int krow = tid / KCH, kcol = (tid % KCH) * 8;
  const int vrow = tid >> 3, vcol = (tid & 7) * 8;
  const unsigned koff = (unsigned)(krow * D + kcol) * 2u, voff = (unsigned)(vrow * MT + vcol) * 2u;
#pragma unroll
  for (int j = 0; j < NKC; ++j) rk[j] = ldg(Kh + (size_t)j * (256 / KCH) * D, koff);
#pragma unroll
  for (int j = 0; j < 4; ++j) rv[j] = ldg(Vt + (size_t)j * 32 * MT, voff);
#pragma unroll
  for (int j = 0; j < NKC; ++j) *(u32x4*)(lds + (krow + j * (256 / KCH)) * KS + kcol) = rk[j];
#pragma unroll
  for (int j = 0; j < 4; ++j) *(u32x4*)(lds + KT + (vrow + 32 * j) * 72 + vcol) = rv[j];
  __syncthreads();
  f32x16 negm;
  {
    f32x16 s0, s1;
#pragma unroll
    for (int r = 0; r < 16; ++r) { s0[r] = 0.f; s1[r] = 0.f; }
#pragma unroll
    for (int s = 0; s < D / 16; ++s) {
      s0 = mfma(*(const bf16x8*)(lds + l31 * KS + 16 * s + 8 * hh), qf[s], s0);
      s1 = mfma(*(const bf16x8*)(lds + (32 + l31) * KS + 16 * s + 8 * hh), qf[s], s1);
    }
    float mx = fmaxf(s0[0], s1[0]);
#pragma unroll
    for (int r = 1; r < 16; ++r) mx = fmaxf(mx, fmaxf(s0[r], s1[r]));
    mx = xmax32(mx);
#pragma unroll
    for (int r = 0; r < 16; ++r) negm[r] = -mx;
  }
  const int ntile = nk >> 6;
#pragma unroll 1
  for (int t = 0; t < ntile; ++t) {
    const bfraw* sK = lds + (t & 1) * STG;
    const bfraw* sV = sK + KT;
    if (t + 1 < ntile) {
      const int key0 = (t + 1) * 64;
#pragma unroll
      for (int j = 0; j < NKC; ++j) rk[j] = ldg(Kh + (size_t)(key0 + j * (256 / KCH)) * D, koff);
#pragma unroll
      for (int j = 0; j < 4; ++j) rv[j] = ldg(Vt + (size_t)j * 32 * MT + key0, voff);
    }
    f32x16 sc[2];
    float pm = 0.f;
    {
      constexpr int NS = D / 16;
      const bfraw* k0p = sK + l31 * KS + 8 * hh;
      const bfraw* k1p = sK + (32 + l31) * KS + 8 * hh;
      bf16x8 ka[NS], kb[NS];
      ka[0] = *(const bf16x8*)(k0p); kb[0] = *(const bf16x8*)(k1p);
      ka[1] = *(const bf16x8*)(k0p + 16); kb[1] = *(const bf16x8*)(k1p + 16);
#pragma unroll
      for (int s = 0; s < NS; ++s) {
        if (s + 2 < NS) { ka[s + 2] = *(const bf16x8*)(k0p + 16 * (s + 2)); kb[s + 2] = *(const bf16x8*)(k1p + 16 * (s + 2)); }
        if (s == 0) { sc[0] = mfma(ka[0], qf[0], negm); sc[1] = mfma(kb[0], qf[0], negm); }
        else { sc[0] = mfma(ka[s], qf[s], sc[0]); sc[1] = mfma(kb[s], qf[s], sc[1]); }
      }
      __builtin_amdgcn_sched_group_barrier(0x100, 4, 0);
#pragma unroll
      for (int s = 0; s < NS; ++s) {
        __builtin_amdgcn_sched_group_barrier(0x008, 2, 0);
        if (s + 2 < NS) __builtin_amdgcn_sched_group_barrier(0x100, 2, 0);
      }
    }
    bf16x8 vf[4];
#pragma unroll
    for (int d = 0; d < 4; ++d) vf[d] = *(const bf16x8*)(sV + (32 * d + l31) * 72 + 8 * hh);
#pragma unroll
    for (int kt = 0; kt < 2; ++kt) {
#pragma unroll
      for (int r = 0; r < 16; ++r) {
        const float p = fexp2(sc[kt][r]);
        sc[kt][r] = p;
        lsum += p;
      }
#pragma unroll
      for (int tt = 0; tt < 2; ++tt) {
        const bf16x8 pf = pack8(sc[kt][8 * tt], sc[kt][8 * tt + 1], sc[kt][8 * tt + 2], sc[kt][8 * tt + 3],
                                sc[kt][8 * tt + 4], sc[kt][8 * tt + 5], sc[kt][8 * tt + 6], sc[kt][8 * tt + 7]);
        bf16x8 vn[4];
        if (kt * 2 + tt < 3) {
#pragma unroll
          for (int d = 0; d < 4; ++d) vn[d] = *(const bf16x8*)(sV + (32 * d + l31) * 72 + 16 * (kt * 2 + tt + 1) + 8 * hh);
        }
#pragma unroll
        for (int d = 0; d < 4; ++d) O[d] = mfma(vf[d], pf, O[d]);
        if (kt * 2 + tt < 3) {
#pragma unroll
          for (int d = 0; d < 4; ++d) vf[d] = vn[d];
        }
      }
#pragma unroll
      for (int r = 0; r < 16; r += 2) pm = fmaxf(pm, fmaxf(sc[kt][r], sc[kt][r + 1]));
    }
    pm = xmax32(pm);
    if (__builtin_amdgcn_ballot_w64(pm > 256.f) != 0) {
      const bool up = pm > 256.f;
      const float alpha = up ? __builtin_amdgcn_rcpf(pm) : 1.f;
      const float dlt = up ? __builtin_amdgcn_logf(pm) : 0.f;
      lsum *= alpha;
#pragma unroll
      for (int d = 0; d < 4; ++d)
#pragma unroll
        for (int r = 0; r < 16; ++r) O[d][r] *= alpha;
#pragma unroll
      for (int r = 0; r < 16; ++r) negm[r] -= dlt;
    }
    if (t + 1 < ntile) {
      bfraw* nK = lds + ((t + 1) & 1) * STG;
#pragma unroll
      for (int j = 0; j < NKC; ++j) *(u32x4*)(nK + (krow + j * (256 / KCH)) * KS + kcol) = rk[j];
#pragma unroll
      for (int j = 0; j < 4; ++j) *(u32x4*)(nK + KT + (vrow + 32 * j) * 72 + vcol) = rv[j];
    }
    __syncthreads();
  }
  lsum = xsum32(lsum);
}

DEV void chain_item(const Params& P, int e, int it, bfraw* lds) {
  const int tid = otid(), lane = tid & 63, w = tid >> 6, l31 = lane & 31, hh = lane >> 5;
  const int dir = it >> 3, head = (it >> 1) & 3, half = it & 1;
  const float lg2 = -__expf(P.ret_decay[e * 8 + dir * 4 + head]) * LOG2E;
  const float cd = exp2f(lg2 * 64.f);
  bfraw* sQ = lds;
  bfraw* sK = lds + 8704;
  bfraw* sKt = lds + 17408;
  bfraw* sV = lds + 26624;
  const bfraw* Qg = (const bfraw*)(P.ws + OFF_QB) + (size_t)head * MT * 128;
  const bfraw* Kg = (const bfraw*)(P.ws + OFF_KB) + (size_t)head * MT * 128;
  const bfraw* Ktg = (const bfraw*)(P.ws + OFF_KBT) + (size_t)(head * 128) * MT;
  const bfraw* Vg = (const bfraw*)(P.ws + OFF_VTB) + (size_t)(head * 256 + half * 128) * MT;
  float* og = (float*)(P.ws + (dir ? OFF_OB : OFF_OF));
  f32x16 St[4];
#pragma unroll
  for (int d = 0; d < 4; ++d)
#pragma unroll
    for (int r = 0; r < 16; ++r) St[d][r] = 0.f;
  u32x4 rq[4], rk[4], rkt[4], rv[4];
  const int qrow = tid >> 4, qcol = (tid & 15) * 8;
  const int trow = tid >> 3, tcol = (tid & 7) * 8;
  const unsigned qoff = (unsigned)(qrow * 128 + qcol) * 2u, toff = (unsigned)(trow * MT + tcol) * 2u;
#pragma unroll 1
  for (int n = 0; n < 260; ++n) {
    const int r0 = dir == 0 ? 64 * n : (n < 4 ? 192 - 64 * n : 16576 - 64 * (n - 4));
    float lg2v = lg2;
    int lanev = lane;
    asm volatile("" : "+v"(lg2v), "+v"(lanev));
    const int l31v = lanev & 31, hhv = lanev >> 5;
    float kdec[8];
#pragma unroll
    for (int e8 = 0; e8 < 8; ++e8) {
      const int slot = (lanev & 7) * 8 + e8;
      const int orig = perm16(slot);
      kdec[e8] = fexp2(lg2v * (float)(dir == 0 ? 63 - orig : orig));
    }
    __syncthreads();
#pragma unroll
    for (int j = 0; j < 4; ++j) {
      rq[j] = ldg(Qg + (size_t)(r0 + 16 * j) * 128, qoff);
      rk[j] = ldg(Kg + (size_t)(r0 + 16 * j) * 128, qoff);
    }
#pragma unroll
    for (int j = 0; j < 4; ++j) {
      *(u32x4*)(sQ + (qrow + 16 * j) * 136 + qcol) = rq[j];
      *(u32x4*)(sK + (qrow + 16 * j) * 136 + qcol) = rk[j];
    }
    __builtin_amdgcn_sched_barrier(0);
#pragma unroll
    for (int j = 0; j < 4; ++j) {
      rkt[j] = ldg(Ktg + (size_t)(32 * j) * MT + r0, toff);
      rv[j] = ldg(Vg + (size_t)(32 * j) * MT + r0, toff);
    }
#pragma unroll
    for (int j = 0; j < 4; ++j) {
      *(u32x4*)(sV + (trow + 32 * j) * 72 + tcol) = rv[j];
      u32x4 u = rkt[j];
      u.x = pk2(bflo(u.x) * kdec[0], bfhi(u.x) * kdec[1]);
      u.y = pk2(bflo(u.y) * kdec[2], bfhi(u.y) * kdec[3]);
      u.z = pk2(bflo(u.z) * kdec[4], bfhi(u.z) * kdec[5]);
      u.w = pk2(bflo(u.w) * kdec[6], bfhi(u.w) * kdec[7]);
      *(u32x4*)(sKt + (trow + 32 * j) * 72 + tcol) = u;
    }
    __syncthreads();
#pragma unroll
    for (int qt = 0; qt < 2; ++qt) {
      f32x16 O;
#pragma unroll
      for (int r = 0; r < 16; ++r) O[r] = 0.f;
#pragma unroll
      for (int dkt = 0; dkt < 4; ++dkt)
#pragma unroll
        for (int tt = 0; tt < 2; ++tt) {
          const bf16x8 af = pack8(St[dkt][8 * tt], St[dkt][8 * tt + 1], St[dkt][8 * tt + 2], St[dkt][8 * tt + 3],
                                  St[dkt][8 * tt + 4], St[dkt][8 * tt + 5], St[dkt][8 * tt + 6], St[dkt][8 * tt + 7]);
          const bfraw* qp = sQ + (32 * qt + l31) * 136 + 32 * dkt + 16 * tt + 4 * hh;
          const u32x2 lo = *(const u32x2*)qp;
          const u32x2 hi = *(const u32x2*)(qp + 8);
          u32x4 u = {lo.x, lo.y, hi.x, hi.y};
          O = mfma(af, __builtin_bit_cast(bf16x8, u), O);
        }
      {
        const int offq = 32 * qt + l31v;
        const float qd = fexp2(lg2v * (float)(dir == 0 ? offq + 1 : 64 - offq));
#pragma unroll
        for (int r = 0; r < 16; ++r) O[r] *= qd;
      }
#pragma unroll
      for (int kt = 0; kt < 2; ++kt) {
        if (dir == 0 ? (kt <= qt) : (kt >= qt)) {
          f32x16 sc;
#pragma unroll
          for (int r = 0; r < 16; ++r) sc[r] = 0.f;
#pragma unroll
          for (int s = 0; s < 8; ++s) {
            const bf16x8 kf = *(const bf16x8*)(sK + (32 * kt + l31) * 136 + 16 * s + 8 * hh);
            const bf16x8 qf = *(const bf16x8*)(sQ + (32 * qt + l31) * 136 + 16 * s + 8 * hh);
            sc = mfma(kf, qf, sc);
          }
          const int offq = 32 * qt + l31v;
#pragma unroll
          for (int r = 0; r < 16; ++r) {
            const int offk = 32 * kt + 8 * (r >> 2) + 4 * hhv + (r & 3);
            const int dl = dir == 0 ? offq - offk : offk - offq;
            sc[r] = dl >= 0 ? sc[r] * fexp2(lg2v * (float)dl) : 0.f;
          }
#pragma unroll
          for (int tt = 0; tt < 2; ++tt) {
            const bf16x8 pf = pack8(sc[8 * tt], sc[8 * tt + 1], sc[8 * tt + 2], sc[8 * tt + 3],
                                    sc[8 * tt + 4], sc[8 * tt + 5], sc[8 * tt + 6], sc[8 * tt + 7]);
            const bf16x8 vf = *(const bf16x8*)(sV + (32 * w + l31) * 72 + 32 * kt + 16 * tt + 8 * hh);
            O = mfma(vf, pf, O);
          }
        }
      }
      float* op = og + (size_t)(r0 + 32 * qt + l31) * 1024 + head * 256 + half * 128 + 32 * w + 4 * hh;
#pragma unroll
      for (int g = 0; g < 4; ++g) {
        f32x4 v = {O[4 * g], O[4 * g + 1], O[4 * g + 2], O[4 * g + 3]};
        *(f32x4*)(op + 8 * g) = v;
      }
    }
#pragma unroll
    for (int d = 0; d < 4; ++d)
#pragma unroll
      for (int r = 0; r < 16; ++r) St[d][r] *= cd;
#pragma unroll
    for (int tt = 0; tt < 4; ++tt) {
      const bf16x8 vf = *(const bf16x8*)(sV + (32 * w + l31) * 72 + 16 * tt + 8 * hh);
#pragma unroll
      for (int dkt = 0; dkt < 4; ++dkt) {
        const bf16x8 kf = *(const bf16x8*)(sKt + (32 * dkt + l31) * 72 + 16 * tt + 8 * hh);
        St[dkt] = mfma(kf, vf, St[dkt]);
      }
    }
  }
  __syncthreads();
}

DEV int next_item(int* ctr, int* s_item) {
  __syncthreads();
  if (otid() == 0) *s_item = atomicAdd(ctr, 1);
  __syncthreads();
  return *s_item;
}

DEV void phase_attn_even(const Params& P, int layer, unsigned char* smem, int* s_item, int cslot) {
  bfraw* lds = (bfraw*)smem;
  const int e = layer >> 1;
  int* ctr = (int*)(P.ws + OFF_CTR) + layer + cslot;
  const int NCH = 16, NLAT = 8 * 128, NCX = 8 * 2;
  const int total = NCH + NLAT + NCX;
  int itq = next_item(ctr, s_item);
#ifndef NO_CHAIN
  while (itq < NCH) { chain_item(P, e, itq, lds); itq = next_item(ctr, s_item); }
#endif
  for (;; itq = next_item(ctr, s_item)) {
    if (itq >= total) break;
    int it = itq - NCH;
    int hd, q0, nk;
    if (it < NLAT) { hd = it >> 7; q0 = 256 + 128 * (it & 127); nk = MT; }
    else { it -= NLAT; hd = it >> 1; q0 = 128 * (it & 1); nk = 256; }
    f32x16 O[4];
    float l;
    const bfraw* Vt = (const bfraw*)(P.ws + OFF_VTA) + (size_t)(hd * 128) * MT;
#pragma unroll 1
    for (int a = 0; a < 2; ++a) {
      const bfraw* Qh = (const bfraw*)(P.ws + OFF_QA) + (size_t)(2 * hd + a) * MT * 64;
      const bfraw* Kh = (const bfraw*)(P.ws + OFF_KA) + (size_t)(2 * hd + a) * MT * 64;
      flash_block<64>(Qh, Kh, Vt, q0, nk, lds, O, l);
      if (a == 0) {
        const float inv = 1.f / l;
        float* tmp = (float*)(P.ws + OFF_DTMP) + (size_t)blockIdx.x * 16384 + (unsigned)otid() * 4u;
#pragma unroll
        for (int d = 0; d < 4; ++d)
#pragma unroll
          for (int g = 0; g < 4; ++g) {
            f32x4 v = {O[d][4 * g] * inv, O[d][4 * g + 1] * inv, O[d][4 * g + 2] * inv, O[d][4 * g + 3] * inv};
            *(f32x4*)(tmp + (size_t)((d * 4 + g) * 256) * 4) = v;
          }
      }
    }
    int zo = 0;
    asm volatile("" : "+v"(zo));
    const float lambda_init = __builtin_fmaf(-0.6f, __expf(-0.3f * (float)(layer + zo)), 0.8f);
    float s01 = 0.f, s23 = 0.f;
    {
      const float* lp = P.diff_lambda + e * 256 + zo;
      for (int i = 0; i < 64; ++i) { s01 += lp[i] * lp[64 + i]; s23 += lp[128 + i] * lp[192 + i]; }
    }
    const float lam = __expf(s01) - __expf(s23) + lambda_init;
    const float c2 = lam / l;
    float ss = 0.f;
    f32x16 O1[4];
    const float* tmp = (const float*)(P.ws + OFF_DTMP) + (size_t)blockIdx.x * 16384 + (unsigned)otid() * 4u;
#pragma unroll
    for (int d = 0; d < 4; ++d)
#pragma unroll
      for (int g = 0; g < 4; ++g) {
        const f32x4 v = *(const f32x4*)(tmp + (size_t)((d * 4 + g) * 256) * 4);
        const float vv[4] = {v.x, v.y, v.z, v.w};
#pragma unroll
        for (int j = 0; j < 4; ++j) {
          const float o = vv[j] - c2 * O[d][4 * g + j];
          O1[d][4 * g + j] = o;
          ss += o * o;
        }
      }
    ss = xsum32(ss);
    const float rstd = rsqrtf(ss * (1.f / 128.f) + EPSN) * (1.f - lambda_init);
    const int tid = otid(), lane = tid & 63, w = tid >> 6, l31 = lane & 31, hh = lane >> 5;
    const int m = q0 + 32 * w + l31;
    const bfraw* gp = (const bfraw*)(P.ws + OFF_GA) + (size_t)m * 1024 + hd * 128 + 4 * hh;
    bfraw* yp = (bfraw*)(P.ws + OFF_H) + (size_t)m * 2048 + hd * 128 + 4 * hh;
    const float* sg = P.diff_subln + e * 128 + 4 * hh;
#pragma unroll
    for (int d = 0; d < 4; ++d)
#pragma unroll
      for (int g = 0; g < 4; ++g) {
        const f32x4 s4 = *(const f32x4*)(sg + 32 * d + 8 * g);
        const u32x2 gg = *(const u32x2*)(gp + 32 * d + 8 * g);
        const float y0 = O1[d][4 * g] * rstd * s4.x * bflo(gg.x);
        const float y1 = O1[d][4 * g + 1] * rstd * s4.y * bfhi(gg.x);
        const float y2 = O1[d][4 * g + 2] * rstd * s4.z * bflo(gg.y);
        const float y3 = O1[d][4 * g + 3] * rstd * s4.w * bfhi(gg.y);
        u32x2 u = {pk2(y0, y1), pk2(y2, y3)};
        *(u32x2*)(yp + 32 * d + 8 * g) = u; __builtin_amdgcn_sched_barrier(0);
      }
  }
}

DEV void phase_attn_odd(const Params& P, int layer, unsigned char* smem, int* s_item, int cslot) {
  bfraw* lds = (bfraw*)smem;
  int* ctr = (int*)(P.ws + OFF_CTR) + layer + cslot;
  const int NLAT = 16 * 128, NCX = (layer < 3) ? 16 * 2 : 0;
  const int total = NLAT + NCX;
  for (;;) {
    int it = next_item(ctr, s_item);
    if (it >= total) break;
    int hq, q0, nk;
    if (it < NLAT) { hq = it >> 7; q0 = 256 + 128 * (it & 127); nk = MT; }
    else { it -= NLAT; hq = it >> 1; q0 = 128 * (it & 1); nk = 256; }
    const int kv = hq >> 2;
    f32x16 O[4];
    float l;
    flash_block<128>((const bfraw*)(P.ws + OFF_QC) + (size_t)hq * MT * 128, (const bfraw*)(P.ws + OFF_KC) + (size_t)kv * MT * 128,
                     (const bfraw*)(P.ws + OFF_VTC) + (size_t)(kv * 128) * MT, q0, nk, lds, O, l);
    const float inv = 1.f / l;
    const int tid = otid(), lane = tid & 63, w = tid >> 6, l31 = lane & 31, hh = lane >> 5;
    const int m = q0 + 32 * w + l31;
    const bfraw* gp = (const bfraw*)(P.ws + OFF_GC) + (size_t)m * 2048 + hq * 128 + 4 * hh;
    bfraw* yp = (bfraw*)(P.ws + OFF_H) + (size_t)m * 2048 + hq * 128 + 4 * hh;
#pragma unroll
    for (int d = 0; d < 4; ++d)
#pragma unroll
      for (int g = 0; g < 4; ++g) {
        const u32x2 gg = *(const u32x2*)(gp + 32 * d + 8 * g);
        const float y0 = O[d][4 * g] * inv * bflo(gg.x);
        const float y1 = O[d][4 * g + 1] * inv * bfhi(gg.x);
        const float y2 = O[d][4 * g + 2] * inv * bflo(gg.y);
        const float y3 = O[d][4 * g + 3] * inv * bfhi(gg.y);
        u32x2 u = {pk2(y0, y1), pk2(y2, y3)};
        *(u32x2*)(yp + 32 * d + 8 * g) = u; __builtin_amdgcn_sched_barrier(0);
      }
  }
}

DEV void phase_comb(const Params& P, int e) {
  const int tid = otid(), lane = tid & 63, w = tid >> 6;
  const float* OFp = (const float*)(P.ws + OFF_OF);
  const float* OBp = (const float*)(P.ws + OFF_OB);
  const bfraw* GB = (const bfraw*)(P.ws + OFF_GB);
  bfraw* Y = (bfraw*)(P.ws + OFF_H);
  for (int idx = blockIdx.x * 4 + w; idx < MT * 4; idx += gridDim.x * 4) {
    const int m = idx >> 2, head = idx & 3;
    const size_t o = (size_t)m * 1024 + head * 256 + lane * 4;
    const f32x4 a = *(const f32x4*)(OFp + o);
    const f32x4 b = *(const f32x4*)(OBp + o);
    float z0 = a.x + b.x, z1 = a.y + b.y, z2 = a.z + b.z, z3 = a.w + b.w;
    const float mu = wave_sum(z0 + z1 + z2 + z3, lane) * (1.f / 256.f);
    z0 -= mu; z1 -= mu; z2 -= mu; z3 -= mu;
    const float var = wave_sum(z0 * z0 + z1 * z1 + z2 * z2 + z3 * z3, lane) * (1.f / 256.f);
    const float rstd = rsqrtf(var + EPSN);
    const f32x4 g4 = *(const f32x4*)(P.ret_gn + e * 1024 + head * 256 + lane * 4);
    const u32x2 gg = *(const u32x2*)(GB + o);
    u32x2 u = {pk2(z0 * rstd * g4.x * bflo(gg.x), z1 * rstd * g4.y * bfhi(gg.x)),
               pk2(z2 * rstd * g4.z * bflo(gg.y), z3 * rstd * g4.w * bfhi(gg.y))};
    *(u32x2*)(Y + (size_t)m * 2048 + 1024 + head * 256 + lane * 4) = u;
  }
}

__global__ void __launch_bounds__(256, 2) mega(Params P) {
  cg::grid_group grid = cg::this_grid();
  __shared__ __attribute__((aligned(16))) unsigned char smem[73728];
  __shared__ int s_item;
  phase0(P, smem);
  grid.sync();
  phase0b(P);
  grid.sync();
#pragma unroll 1
  for (int layer = 0; layer < 4; ++layer) {
    phase_norm(P, layer);
    grid.sync();
    int nrep_g = (PROBE_DUP == 2) ? 2 : 1, nrep_a = (PROBE_DUP == 1) ? 2 : 1;
    asm volatile("" : "+s"(nrep_g), "+s"(nrep_a));
#pragma unroll 1
    for (int rep = 0; rep < nrep_g; ++rep) {
      phase_gemm(P, layer, layer & 1, smem);
      grid.sync();
    }
#pragma unroll 1
    for (int rep = 0; rep < nrep_a; ++rep) {
      if (layer & 1) phase_attn_odd(P, layer, smem, &s_item, 4 * rep);
      else phase_attn_even(P, layer, smem, &s_item, 4 * rep);
      if (rep + 1 < nrep_a) grid.sync();
    }
    if (!(layer & 1)) {
      grid.sync();
      phase_comb(P, layer >> 1);
    }
    grid.sync();
    phase_gemm(P, layer, 2, smem);
    grid.sync();
  }
  phase_final(P);
}

extern "C" void kernel_launch(void* const* d_in, const int* in_sizes, int n_in, void* d_out, int out_size, void* d_ws,
                              size_t ws_size, hipStream_t stream) {
  static int grid_blocks = 0;
  if (grid_blocks == 0) {
    if (n_in != 17 || ws_size < WS_END) {
      fprintf(stderr, "kernel_launch: need 17 inputs and >= %zu bytes of workspace; got %d inputs, %zu bytes\n", (size_t)WS_END, n_in, ws_size);
      grid_blocks = -1;
      return;
    }
    int dev = 0, cus = 0, per_cu = 0;
    hipGetDevice(&dev);
    hipDeviceGetAttribute(&cus, hipDeviceAttributeMultiprocessorCount, dev);
    hipOccupancyMaxActiveBlocksPerMultiprocessor(&per_cu, (const void*)mega, 256, 0);
    if (per_cu > 2) per_cu = 2;
    if (per_cu < 1) per_cu = 1;
    grid_blocks = cus * per_cu;
  }
  if (grid_blocks < 0) return;
  Params p{};
  p.x = (const float*)d_in[0]; p.c = (const float*)d_in[1]; p.ctx = (const float*)d_in[2]; p.c_ctx = (const float*)d_in[3];
  p.norm_g = (const float*)d_in[4]; p.w_mod = (const float*)d_in[5]; p.b_mod = (const float*)d_in[6];
  p.ev_w_in = (const float*)d_in[7]; p.ev_w_out = (const float*)d_in[8]; p.diff_lambda = (const float*)d_in[9];
  p.diff_subln = (const float*)d_in[10]; p.ret_decay = (const float*)d_in[11]; p.ret_gn = (const float*)d_in[12];
  p.od_w_in = (const float*)d_in[13]; p.od_w_out = (const float*)d_in[14]; p.qk_norm = (const float*)d_in[15];
  p.final_norm = (const float*)d_in[16];
  p.out = (float*)d_out; p.ws = (unsigned char*)d_ws;
  void* args[] = {&p};
  hipError_t e = hipLaunchCooperativeKernel((const void*)mega, dim3(grid_blocks), dim3(256), args, 0, stream);
  if (e != hipSuccess) fprintf(stderr, "cooperative launch failed: %s (grid %d)\n", hipGetErrorString(e), grid_blocks);
}
```

```cpp
#include <hip/hip_runtime.h>
#include <hip/hip_cooperative_groups.h>
#include <cstdio>
namespace cg = cooperative_groups;
#ifndef PROBE_DUP
#define PROBE_DUP 0
#endif
#ifndef PROBE_TSA
#define PROBE_TSA -1
#define PROBE_TSB -1
#define PROBE_TSS 1e-5f
#endif

typedef unsigned short bfraw;
typedef __attribute__((ext_vector_type(8))) __bf16 bf16x8;
typedef __attribute__((ext_vector_type(2))) __bf16 bf16x2;
typedef __attribute__((ext_vector_type(2))) float f32x2;
typedef __attribute__((ext_vector_type(16))) float f32x16;
typedef __attribute__((ext_vector_type(4))) float f32x4;
typedef __attribute__((ext_vector_type(4))) unsigned u32x4;
typedef __attribute__((ext_vector_type(2))) unsigned u32x2;

#define DEV static __device__ __forceinline__

constexpr int MT = 16640;
constexpr int DM = 2048;
constexpr float LOG2E = 1.4426950408889634f;
constexpr float EPSN = 1e-6f;

constexpr size_t OFF_WT_EVIN  = 0;
constexpr size_t OFF_WT_EVOUT = OFF_WT_EVIN + (size_t)2 * 7168 * 2048 * 2;
constexpr size_t OFF_WT_ODIN  = OFF_WT_EVOUT + (size_t)2 * 2048 * 2048 * 2;
constexpr size_t OFF_WT_ODOUT = OFF_WT_ODIN + (size_t)2 * 5120 * 2048 * 2;
constexpr size_t OFF_MODPART  = OFF_WT_ODOUT + (size_t)2 * 2048 * 2048 * 2;
constexpr size_t OFF_MODV     = OFF_MODPART + (size_t)16 * 4 * 2 * 6144 * 4;
constexpr size_t OFF_ROPE     = OFF_MODV + (size_t)4 * 2 * 6144 * 4;
constexpr size_t OFF_CTR      = OFF_ROPE + (size_t)(8192 + 16384) * 4;
constexpr size_t OFF_BAR      = OFF_CTR + 256;
constexpr size_t OFF_CTXRES   = OFF_BAR + 16384;
constexpr size_t OFF_H        = OFF_CTXRES + (size_t)256 * 2048 * 4;
constexpr size_t OFF_PROJ     = OFF_H + (size_t)MT * 2048 * 2;
constexpr size_t SZ_A         = (size_t)MT * 1024 * 2;
constexpr size_t SZ_B         = (size_t)MT * 512 * 2;
constexpr size_t OFF_QA  = OFF_PROJ;
constexpr size_t OFF_KA  = OFF_QA + SZ_A;
constexpr size_t OFF_VTA = OFF_KA + SZ_A;
constexpr size_t OFF_GA  = OFF_VTA + SZ_A;
constexpr size_t OFF_QB  = OFF_GA + SZ_A;
constexpr size_t OFF_KB  = OFF_QB + SZ_B;
constexpr size_t OFF_KBT = OFF_KB + SZ_B;
constexpr size_t OFF_VTB = OFF_KBT + SZ_B;
constexpr size_t OFF_GB  = OFF_VTB + SZ_A;
constexpr size_t OFF_PROJ_END = OFF_GB + SZ_A;
constexpr size_t OFF_QC  = OFF_PROJ;
constexpr size_t OFF_KC  = OFF_QC + 2 * SZ_A;
constexpr size_t OFF_VTC = OFF_KC + SZ_B;
constexpr size_t OFF_GC  = OFF_VTC + SZ_B;
constexpr size_t OFF_OF  = OFF_PROJ_END;
constexpr size_t OFF_OB  = OFF_OF + (size_t)MT * 1024 * 4;
constexpr size_t OFF_DTMP = OFF_OB + (size_t)MT * 1024 * 4;
constexpr size_t OFF_PART = OFF_DTMP + (size_t)512 * 256 * 64 * 4;
constexpr size_t WS_END  = OFF_PART + (size_t)16 * 10 * 2 * 17 * 1024 * 4;

struct Params {
  const float *x, *c, *ctx, *c_ctx, *norm_g, *w_mod, *b_mod, *ev_w_in, *ev_w_out, *diff_lambda, *diff_subln,
      *ret_decay, *ret_gn, *od_w_in, *od_w_out, *qk_norm, *final_norm;
  float* out;
  unsigned char* ws;
};

DEV f32x16 mfma(bf16x8 a, bf16x8 b, f32x16 c) { return __builtin_amdgcn_mfma_f32_32x32x16_bf16(a, b, c, 0, 0, 0); }
DEV unsigned pk2(float a, float b) {
  f32x2 v = {a, b};
  bf16x2 r = __builtin_convertvector(v, bf16x2);
  return __builtin_bit_cast(unsigned, r);
}
DEV u32x4 ldg(const bfraw* ubase, unsigned voff) { return *(const u32x4*)((const char*)ubase + voff); }
DEV u32x4 ldgu(const bfraw* ubase, unsigned voff) {
  const unsigned long long b = (unsigned long long)ubase;
  const unsigned lo = __builtin_amdgcn_readfirstlane((unsigned)b), hi = __builtin_amdgcn_readfirstlane((unsigned)(b >> 32));
  const char* sb = (const char*)(((unsigned long long)hi << 32) | lo);
  return *(const u32x4*)(sb + voff);
}
DEV int otid() {
  const int wv = __builtin_amdgcn_readfirstlane((int)threadIdx.x >> 6);
  int t = wv * 64 + (int)__builtin_amdgcn_mbcnt_hi(~0u, __builtin_amdgcn_mbcnt_lo(~0u, 0u));
  asm volatile("" : "+v"(t));
  return t;
}
DEV float bflo(unsigned u) { return __uint_as_float(u << 16); }
DEV float bfhi(unsigned u) { return __uint_as_float(u & 0xffff0000u); }
DEV bf16x8 pack8(float a0, float a1, float a2, float a3, float a4, float a5, float a6, float a7) {
  u32x4 u = {pk2(a0, a1), pk2(a2, a3), pk2(a4, a5), pk2(a6, a7)};
  return __builtin_bit_cast(bf16x8, u);
}
DEV bfraw f2bf(float a) { return (bfraw)(pk2(a, 0.f) & 0xffffu); }
DEV float fexp2(float x) { return __builtin_amdgcn_exp2f(x); }
DEV float wave_sum(float v, int lane) {
#pragma unroll
  for (int o = 1; o < 64; o <<= 1) v += __int_as_float(__builtin_amdgcn_ds_bpermute((lane ^ o) << 2, __float_as_int(v)));
  return v;
}
DEV float xsum32(float x) {
  const u32x2 r = __builtin_amdgcn_permlane32_swap(__float_as_uint(x), __float_as_uint(x), false, false);
  return __uint_as_float(r.x) + __uint_as_float(r.y);
}
DEV float xmax32(float x) {
  const u32x2 r = __builtin_amdgcn_permlane32_swap(__float_as_uint(x), __float_as_uint(x), false, false);
  return fmaxf(__uint_as_float(r.x), __uint_as_float(r.y));
}
DEV float uni(float x) { return __int_as_float(__builtin_amdgcn_readfirstlane(__float_as_int(x))); }
DEV float siluf(float v) { return v / (1.f + __expf(-v)); }
DEV void lds_barrier() { asm volatile("s_waitcnt lgkmcnt(0)\n\ts_barrier" ::: "memory"); }
DEV int perm16(int m) {
  int b = (m >> 2) & 3;
  int b2 = ((b & 1) << 1) | (b >> 1);
  return (m & ~12) | (b2 << 2);
}

DEV const float* res_src(const Params& P, int layer, int row) {
  if (row < 256) return (layer == 0 ? P.ctx : (const float*)(P.ws + OFF_CTXRES)) + (size_t)row * DM;
  return (layer == 0 ? P.x : (const float*)P.out) + (size_t)(row - 256) * DM;
}
DEV float* res_dst(const Params& P, int row) {
  if (row < 256) return (float*)(P.ws + OFF_CTXRES) + (size_t)row * DM;
  return P.out + (size_t)(row - 256) * DM;
}

#define XB_TMO      128
#define XB_XCNT(j)  (256  + 64 * (j))
#define XB_XSUB(j)  (1280 + 64 * (j))
#define XB_XGEN(j)  (2304 + 64 * (j))
#define XB_TOP      3328
#define XB_TOPGEN   3392
#define XCD_BAR_WORDS 3456
#define XB_SPIN_CAP (1u << 22)
#define LAS __attribute__((address_space(3)))
DEV unsigned xb_ld(unsigned* p) { return __hip_atomic_load(p, __ATOMIC_RELAXED, __HIP_MEMORY_SCOPE_AGENT); }
DEV unsigned xb_add(unsigned* p, unsigned v) { return __hip_atomic_fetch_add(p, v, __ATOMIC_RELAXED, __HIP_MEMORY_SCOPE_AGENT); }
DEV unsigned xb_xcc_id() { return (unsigned)__builtin_amdgcn_s_getreg((3 << 11) | 20) & 0xFu; }
#define XB_SPIN(cond, bar) do { unsigned _sp = 0; while (cond) { __builtin_amdgcn_s_sleep(1); \
    if ((++_sp & 255u) == 0u) { if (xb_ld(&(bar)[XB_TMO])) break; if (_sp > XB_SPIN_CAP) { atomicAdd(&(bar)[XB_TMO], 1u); break; } } } } while (0)
struct XcdBarrier { unsigned* bar; unsigned x; volatile LAS unsigned* st; };
DEV XcdBarrier xcd_barrier_post(unsigned* bar, volatile LAS unsigned* st) {
  XcdBarrier b; b.bar = bar; b.x = xb_xcc_id(); b.st = st;
  if (otid() == 0) (void)xb_add(&bar[XB_XCNT(b.x)], 1u);
  return b;
}
DEV void xcd_barrier_complete(unsigned* bar, unsigned x, unsigned& nloc, unsigned& nx) {
  const unsigned G = gridDim.x;
  unsigned sum, cnt, mine, sp = 0u;
  for (;;) {
    sum = 0u; cnt = 0u; mine = 0u;
#pragma unroll
    for (unsigned j = 0; j < 16; ++j) { const unsigned c = xb_ld(&bar[XB_XCNT(j)]); sum += c; cnt += (c > 0u) ? 1u : 0u; mine = (j == x) ? c : mine; }
    if (sum == G) break;
    __builtin_amdgcn_s_sleep(1);
    if ((++sp & 255u) == 0u) { if (xb_ld(&bar[XB_TMO])) break; if (sp > XB_SPIN_CAP) { atomicAdd(&bar[XB_TMO], 1u); break; } }
  }
  nloc = mine > 0u ? mine : 1u; nx = cnt > 0u ? cnt : 1u;
}
DEV void xcd_barrier(const XcdBarrier& b) {
  asm volatile("s_waitcnt vmcnt(0)" ::: "memory");
  __syncthreads();
  if (otid() == 0) {
    unsigned* bar = b.bar;
    __builtin_amdgcn_s_waitcnt(0);
    unsigned nloc = b.st[0], nx = b.st[1];
    if (nloc == 0u) { xcd_barrier_complete(bar, b.x, nloc, nx); b.st[0] = nloc; b.st[1] = nx; }
    const unsigned old = xb_add(&bar[XB_XSUB(b.x)], 1u);
    const unsigned gen = old / nloc;
    if (old + 1u == (gen + 1u) * nloc) {
      __builtin_amdgcn_fence(__ATOMIC_RELEASE, "agent");
      asm volatile("s_waitcnt vmcnt(0)" ::: "memory");
      const unsigned og = xb_add(&bar[XB_TOP], 1u);
      const unsigned tg = og / nx;
      if (og + 1u == (tg + 1u) * nx) xb_add(&bar[XB_TOPGEN], 1u);
      else XB_SPIN(xb_ld(&bar[XB_TOPGEN]) == tg, bar);
      __builtin_amdgcn_fence(__ATOMIC_ACQUIRE, "agent");
      xb_add(&bar[XB_XGEN(b.x)], 1u);
      asm volatile("s_waitcnt vmcnt(0)" ::: "memory");
    } else {
      XB_SPIN(xb_ld(&bar[XB_XGEN(b.x)]) == gen, bar);
      __builtin_amdgcn_fence(__ATOMIC_ACQUIRE, "agent");
      asm volatile("s_waitcnt vmcnt(0)" ::: "memory");
    }
  }
  __syncthreads();
}


DEV void phase0(const Params& P, unsigned char* smem) {
  const int tid = otid();
  const int gtid = blockIdx.x * 256 + tid, gsz = gridDim.x * 256;
  if (gtid < 16) ((int*)(P.ws + OFF_CTR))[gtid] = 0;
  float* rope = (float*)(P.ws + OFF_ROPE);
  for (int i = gtid; i < 4096 + 8192; i += gsz) {
    int pos, f; float inv; float *pc, *ps;
    if (i < 4096) { pos = i >> 4; f = i & 15; inv = exp2f(-(float)f * (13.287712379549449f / 16.f)); pc = rope + i; ps = rope + 4096 + i; }
    else { int j = i - 4096; pos = j >> 5; f = j & 31; inv = exp2f(-(float)f * (13.287712379549449f / 32.f)); pc = rope + 8192 + j; ps = rope + 16384 + j; }
    float ang = (float)pos * inv;
    double a = (double)ang;
    double kk = rint(a * 0.15915494309189535);
    float r = (float)(a - kk * 6.283185307179586);
    *pc = __cosf(r); *ps = __sinf(r);
  }
  const int NG = 4 * 16 * 6, NTT = 16384;
  for (int it = blockIdx.x; it < NG + NTT; it += gridDim.x) {
    if (it < NG) {
      const int layer = it / 96, rem = it % 96, kc = rem / 6, ng = rem % 6;
      const int n = ng * 1024 + tid * 4;
      const float* W = P.w_mod + ((size_t)layer * 2048 + kc * 128) * 6144 + n;
      f32x4 al = {0.f, 0.f, 0.f, 0.f}, ac = {0.f, 0.f, 0.f, 0.f};
#pragma unroll 8
      for (int k = 0; k < 128; ++k) {
        const float cl = P.c[kc * 128 + k], cc = P.c_ctx[kc * 128 + k];
        const float sl = siluf(cl), sx = siluf(cc);
        const f32x4 w4 = *(const f32x4*)(W + (size_t)k * 6144);
        al.x += sl * w4.x; al.y += sl * w4.y; al.z += sl * w4.z; al.w += sl * w4.w;
        ac.x += sx * w4.x; ac.y += sx * w4.y; ac.z += sx * w4.z; ac.w += sx * w4.w;
      }
      float* part = (float*)(P.ws + OFF_MODPART) + ((size_t)(kc * 4 + layer) * 2) * 6144;
      *(f32x4*)(part + n) = al;
      *(f32x4*)(part + 6144 + n) = ac;
    } else {
      int t = it - NG;
      const float* src; bfraw* dst; int N;
      if (t < 7168) { int l = t / 3584; t -= l * 3584; N = 7168; src = P.ev_w_in + (size_t)l * 2048 * 7168; dst = (bfraw*)(P.ws + OFF_WT_EVIN) + (size_t)l * 7168 * 2048; }
      else if (t < 7168 + 2048) { t -= 7168; int l = t / 1024; t -= l * 1024; N = 2048; src = P.ev_w_out + (size_t)l * 2048 * 2048; dst = (bfraw*)(P.ws + OFF_WT_EVOUT) + (size_t)l * 2048 * 2048; }
      else if (t < 7168 + 2048 + 5120) { t -= 9216; int l = t / 2560; t -= l * 2560; N = 5120; src = P.od_w_in + (size_t)l * 2048 * 5120; dst = (bfraw*)(P.ws + OFF_WT_ODIN) + (size_t)l * 5120 * 2048; }
      else { t -= 14336; int l = t / 1024; t -= l * 1024; N = 2048; src = P.od_w_out + (size_t)l * 2048 * 2048; dst = (bfraw*)(P.ws + OFF_WT_ODOUT) + (size_t)l * 2048 * 2048; }
      const int ntn = N >> 6;
      const int ntile = t % ntn, ktile = t / ntn;
      float* sT = (float*)smem;
#pragma unroll
      for (int j = 0; j < 4; ++j) {
        const int idx = tid + 256 * j, krow = idx >> 4, c4 = idx & 15;
        const f32x4 v = *(const f32x4*)(src + (size_t)(ktile * 64 + krow) * N + ntile * 64 + c4 * 4);
        float* d = sT + krow * 65 + c4 * 4;
        d[0] = v.x; d[1] = v.y; d[2] = v.z; d[3] = v.w;
      }
      __syncthreads();
#pragma unroll
      for (int j = 0; j < 2; ++j) {
        const int idx = tid + 256 * j, kg = idx & 7, n = idx >> 3;
        const float* s = sT + (kg * 8) * 65 + n;
        u32x4 u = {pk2(s[0], s[65]), pk2(s[130], s[195]), pk2(s[260], s[325]), pk2(s[390], s[455])};
        *(u32x4*)(dst + (size_t)(ntile * 64 + n) * 2048 + ktile * 64 + kg * 8) = u;
      }
      __syncthreads();
    }
  }
}

DEV void phase0b(const Params& P) {
  const int gtid = blockIdx.x * 256 + otid(), gsz = gridDim.x * 256;
  const float* part = (const float*)(P.ws + OFF_MODPART);
  float* modv = (float*)(P.ws + OFF_MODV);
  for (int i = gtid; i < 4 * 2 * 6144; i += gsz) {
    const int layer = i / 12288, rem = i % 12288, which = rem / 6144, n = rem % 6144;
    float s = P.b_mod[layer * 6144 + n];
#pragma unroll
    for (int kc = 0; kc < 16; ++kc) s += part[((size_t)(kc * 4 + layer) * 2 + which) * 6144 + n];
    modv[i] = s;
  }
}

DEV void phase_norm(const Params& P, int layer) {
  const int tid = otid(), lane = tid & 63, w = tid >> 6;
  const float* g = P.norm_g + layer * 2048;
  const float* modv = (const float*)(P.ws + OFF_MODV) + (size_t)layer * 2 * 6144;
  bfraw* H = (bfraw*)(P.ws + OFF_H);
  const int gw = blockIdx.x * 4 + w, nw = gridDim.x * 4;
#pragma unroll 1
  for (int kind = 0; kind < 2; ++kind) {
    const int rbeg = kind ? 256 : 0, rend = kind ? MT : 256;
    const float* mv = modv + (kind ? 0 : 6144);
    int row = rbeg + gw;
    if (row >= rend) continue;
    f32x4 mul[8], add[8];
#pragma unroll
    for (int it = 0; it < 8; ++it) {
      const int c = (it * 64 + lane) * 4;
      const f32x4 g4 = *(const f32x4*)(g + c);
      const f32x4 sc = *(const f32x4*)(mv + 2048 + c);
      add[it] = *(const f32x4*)(mv + c);
      mul[it] = g4 * (1.f + sc);
    }
    f32x4 v[8];
    {
      const float* src = res_src(P, layer, row);
#pragma unroll
      for (int it = 0; it < 8; ++it) v[it] = *(const f32x4*)(src + (it * 64 + lane) * 4);
    }
#pragma unroll 1
    for (; row < rend; row += nw) {
      f32x4 nv[8];
      const int nrow = row + nw < rend ? row + nw : row;
      {
        const float* src = res_src(P, layer, nrow);
#pragma unroll
        for (int it = 0; it < 8; ++it) nv[it] = *(const f32x4*)(src + (it * 64 + lane) * 4);
      }
      float ss = 0.f;
#pragma unroll
      for (int it = 0; it < 8; ++it) ss += v[it].x * v[it].x + v[it].y * v[it].y + v[it].z * v[it].z + v[it].w * v[it].w;
      ss = wave_sum(ss, lane);
      const float rstd = rsqrtf(ss * (1.f / 2048.f) + EPSN);
#pragma unroll
      for (int it = 0; it < 8; ++it) {
        const int c = (it * 64 + lane) * 4;
        const f32x4 y = v[it] * rstd * mul[it] + add[it];
        u32x2 u = {pk2(y.x, y.y), pk2(y.z, y.w)};
        *(u32x2*)(H + (size_t)row * 2048 + c) = u;
      }
#pragma unroll
      for (int it = 0; it < 8; ++it) v[it] = nv[it];
    }
  }
}

DEV void phase_final(const Params& P) {
  const int tid = otid(), lane = tid & 63, w = tid >> 6;
  const int gw = blockIdx.x * 4 + w, nw = gridDim.x * 4;
  f32x4 g4[8];
#pragma unroll
  for (int it = 0; it < 8; ++it) g4[it] = *(const f32x4*)(P.final_norm + (it * 64 + lane) * 4);
  int row = gw;
  if (row >= 16384) return;
  f32x4 v[8];
#pragma unroll
  for (int it = 0; it < 8; ++it) v[it] = *(const f32x4*)(P.out + (size_t)row * DM + (it * 64 + lane) * 4);
#pragma unroll 1
  for (; row < 16384; row += nw) {
    f32x4 nv[8];
    const int nrow = row + nw < 16384 ? row + nw : row;
#pragma unroll
    for (int it = 0; it < 8; ++it) nv[it] = *(const f32x4*)(P.out + (size_t)nrow * DM + (it * 64 + lane) * 4);
    float* src = P.out + (size_t)row * DM;
    float ss = 0.f;
#pragma unroll
    for (int it = 0; it < 8; ++it) ss += v[it].x * v[it].x + v[it].y * v[it].y + v[it].z * v[it].z + v[it].w * v[it].w;
    ss = wave_sum(ss, lane);
    const float rstd = rsqrtf(ss * (1.f / 2048.f) + EPSN);
#pragma unroll
    for (int it = 0; it < 8; ++it) {
      const int c = (it * 64 + lane) * 4;
      f32x4 y = v[it] * rstd * g4[it];
#if PROBE_TSA >= 0
      {
        const unsigned long long* ts = (const unsigned long long*)(P.ws + OFF_BAR + 14336);
        const float us = (float)(long long)(ts[PROBE_TSB] - ts[PROBE_TSA]) * 0.01f;
        y *= (1.f + PROBE_TSS * us);
      }
#endif
      *(f32x4*)(src + c) = y;
    }
#pragma unroll
    for (int it = 0; it < 8; ++it) v[it] = nv[it];
  }
}

template <bool FEAT>
DEV void gemm_step(const bfraw* cA, const bfraw* cB, int w, int l31, int hh, f32x16 (&acc)[4]) {
  const bfraw* pm = cA + (32 * w + l31) * 72 + hh * 8;
  const bfraw* pn = cB + l31 * 72 + hh * 8;
  bf16x8 fm[4], fn[4][4];
  fm[0] = *(const bf16x8*)pm;
#pragma unroll
  for (int nt = 0; nt < 4; ++nt) fn[0][nt] = *(const bf16x8*)(pn + 32 * nt * 72);
#pragma unroll
  for (int s = 0; s < 4; ++s) {
    if (s < 3) {
      fm[s + 1] = *(const bf16x8*)(pm + (s + 1) * 16);
#pragma unroll
      for (int nt = 0; nt < 4; ++nt) fn[s + 1][nt] = *(const bf16x8*)(pn + 32 * nt * 72 + (s + 1) * 16);
    }
#pragma unroll
    for (int nt = 0; nt < 4; ++nt) {
      if (FEAT) acc[nt] = mfma(fm[s], fn[s][nt], acc[nt]);
      else acc[nt] = mfma(fn[s][nt], fm[s], acc[nt]);
    }
  }
  __builtin_amdgcn_sched_group_barrier(0x100, 5, 0);
#pragma unroll
  for (int s = 0; s < 3; ++s) {
    __builtin_amdgcn_sched_group_barrier(0x008, 1, 0);
    __builtin_amdgcn_sched_group_barrier(0x100, 2, 0);
    __builtin_amdgcn_sched_group_barrier(0x008, 1, 0);
    __builtin_amdgcn_sched_group_barrier(0x100, 1, 0);
    __builtin_amdgcn_sched_group_barrier(0x008, 1, 0);
    __builtin_amdgcn_sched_group_barrier(0x100, 1, 0);
    __builtin_amdgcn_sched_group_barrier(0x008, 1, 0);
    __builtin_amdgcn_sched_group_barrier(0x100, 1, 0);
  }
  __builtin_amdgcn_sched_group_barrier(0x008, 4, 0);
}

template <bool FEAT>
DEV void gemm_main(const bfraw* A, const bfraw* W, int m0, int n0, bfraw* lds, f32x16 (&acc)[4]) {
  const int tid = otid(), lane = tid & 63, w = tid >> 6, l31 = lane & 31, hh = lane >> 5;
  const int srow = tid >> 3, scol = (tid & 7) * 8;
  const bfraw* ap = A + (size_t)m0 * 2048;
  const bfraw* wp = W + (size_t)n0 * 2048;
  const unsigned goff = (unsigned)(srow * 2048 + scol) * 2u;
  u32x4 ra0[4], rw0[4], ra1[4], rw1[4];
#pragma unroll
  for (int j = 0; j < 4; ++j) {
    ra0[j] = ldg(ap + (size_t)j * 32 * 2048, goff);
    rw0[j] = ldg(wp + (size_t)j * 32 * 2048, goff);
  }
#pragma unroll
  for (int j = 0; j < 4; ++j) {
    ra1[j] = ldg(ap + (size_t)j * 32 * 2048 + 64, goff);
    rw1[j] = ldg(wp + (size_t)j * 32 * 2048 + 64, goff);
  }
#pragma unroll
  for (int nt = 0; nt < 4; ++nt)
#pragma unroll
    for (int r = 0; r < 16; ++r) acc[nt][r] = 0.f;
#pragma unroll
  for (int j = 0; j < 4; ++j) {
    *(u32x4*)(lds + (srow + 32 * j) * 72 + scol) = ra0[j];
    *(u32x4*)(lds + 9216 + (srow + 32 * j) * 72 + scol) = rw0[j];
  }
#pragma unroll
  for (int j = 0; j < 4; ++j) {
    ra0[j] = ldg(ap + (size_t)j * 32 * 2048 + 128, goff);
    rw0[j] = ldg(wp + (size_t)j * 32 * 2048 + 128, goff);
  }
  lds_barrier();
#pragma unroll 1
  for (int kt = 0; kt < 32; kt += 2) {
    gemm_step<FEAT>(lds, lds + 9216, w, l31, hh, acc);
#pragma unroll
    for (int j = 0; j < 4; ++j) {
      *(u32x4*)(lds + 18432 + (srow + 32 * j) * 72 + scol) = ra1[j];
      *(u32x4*)(lds + 18432 + 9216 + (srow + 32 * j) * 72 + scol) = rw1[j];
    }
    if (kt + 3 < 32) {
#pragma unroll
      for (int j = 0; j < 4; ++j) {
        ra1[j] = ldg(ap + (size_t)j * 32 * 2048 + (kt + 3) * 64, goff);
        rw1[j] = ldg(wp + (size_t)j * 32 * 2048 + (kt + 3) * 64, goff);
      }
    }
    lds_barrier();
    gemm_step<FEAT>(lds + 18432, lds + 18432 + 9216, w, l31, hh, acc);
    if (kt + 2 < 32) {
#pragma unroll
      for (int j = 0; j < 4; ++j) {
        *(u32x4*)(lds + (srow + 32 * j) * 72 + scol) = ra0[j];
        *(u32x4*)(lds + 9216 + (srow + 32 * j) * 72 + scol) = rw0[j];
      }
    }
    if (kt + 4 < 32) {
#pragma unroll
      for (int j = 0; j < 4; ++j) {
        ra0[j] = ldg(ap + (size_t)j * 32 * 2048 + (kt + 4) * 64, goff);
        rw0[j] = ldg(wp + (size_t)j * 32 * 2048 + (kt + 4) * 64, goff);
      }
    }
    lds_barrier();
  }
}

template <bool FEAT>
DEV void tile_store(bfraw* lds, const u32x2 (&pk)[4][4], bfraw* base, size_t R0, size_t rstride, size_t C0, size_t hoff) {
  const int tid = otid(), lane = tid & 63, w = tid >> 6, l31 = lane & 31, hh = lane >> 5;
#pragma unroll
  for (int nt = 0; nt < 4; ++nt)
#pragma unroll
    for (int g = 0; g < 4; ++g) {
      const int row = FEAT ? 32 * nt + l31 : 32 * w + l31;
      const int col = FEAT ? 32 * w + 16 * (g >> 1) + 8 * hh + 4 * (g & 1) : 32 * nt + 8 * g + 4 * hh;
      *(u32x2*)(lds + row * 136 + col) = pk[nt][g];
    }
  lds_barrier();
#pragma unroll
  for (int j = 0; j < 8; ++j) {
    const int c = tid + 256 * j, row = c >> 4, cc = c & 15;
    const u32x4 v = *(const u32x4*)(lds + row * 136 + cc * 8);
    *(u32x4*)(base + (R0 + row) * rstride + C0 + cc * 8 + (size_t)(cc >> 3) * hoff) = v;
  }
  lds_barrier();
}

DEV void phase_gemm(const Params& P, int layer, int kind, unsigned char* smem) {
  const int tid = otid(), lane = tid & 63, w = tid >> 6, l31 = lane & 31, hh = lane >> 5;
  bfraw* lds = (bfraw*)smem;
  const int eo = layer >> 1;
  const bfraw* A = (const bfraw*)(P.ws + OFF_H);
  const bfraw* W;
  int NTN, mt0 = 0;
  if (kind == 0) { W = (const bfraw*)(P.ws + OFF_WT_EVIN) + (size_t)eo * 7168 * 2048; NTN = 56; }
  else if (kind == 1) { W = (const bfraw*)(P.ws + OFF_WT_ODIN) + (size_t)eo * 5120 * 2048; NTN = 40; }
  else { W = (const bfraw*)(P.ws + ((layer & 1) ? OFF_WT_ODOUT : OFF_WT_EVOUT)) + (size_t)eo * 2048 * 2048; NTN = 16; if (layer == 3) mt0 = 2; }
  const float* rope = (const float*)(P.ws + OFF_ROPE);
  const int ntiles = (130 - mt0) * NTN;
  for (int t = blockIdx.x; t < ntiles; t += gridDim.x) {
    const int mt = mt0 + t / NTN, tn = t % NTN;
    const int m0 = mt * 128, n0 = tn * 128;
    f32x16 acc[4];
    u32x2 pk[4][4];
    int vcol = -1; bfraw* vdst = nullptr;
    if (kind == 0) {
      if (tn >= 16 && tn < 24) { vcol = (tn - 16) * 128; vdst = (bfraw*)(P.ws + OFF_VTA); }
      else if (tn >= 40 && tn < 48) { vcol = (tn - 40) * 128; vdst = (bfraw*)(P.ws + OFF_VTB); }
    } else if (kind == 1) {
      if (tn >= 20 && tn < 24) { vcol = (tn - 20) * 128; vdst = (bfraw*)(P.ws + OFF_VTC); }
    }
    if (vcol >= 0) {
      gemm_main<true>(A, W, m0, n0, lds, acc);
#pragma unroll
      for (int nt = 0; nt < 4; ++nt)
#pragma unroll
        for (int g = 0; g < 4; ++g) {
          u32x2 u = {pk2(acc[nt][4 * g], acc[nt][4 * g + 1]), pk2(acc[nt][4 * g + 2], acc[nt][4 * g + 3])};
          pk[nt][g] = u;
        }
      tile_store<true>(lds, pk, vdst, (size_t)vcol, (size_t)MT, (size_t)m0, 0);
      continue;
    }
    if (kind == 2) {
      gemm_main<true>(A, W, m0, n0, lds, acc);
      const bool latr = m0 >= 256;
      const float* gate = (const float*)(P.ws + OFF_MODV) + ((size_t)layer * 2 + (latr ? 0 : 1)) * 6144 + 4096 + n0 + l31;
      float gt[4];
#pragma unroll
      for (int nt = 0; nt < 4; ++nt) gt[nt] = gate[32 * nt];
#pragma unroll
      for (int g = 0; g < 4; ++g)
#pragma unroll
        for (int j = 0; j < 4; ++j) {
          const int mr = m0 + 32 * w + 8 * g + 4 * hh + j;
          const float* sp = res_src(P, layer, mr) + n0 + l31;
          float* dp = res_dst(P, mr) + n0 + l31;
          float xv[4];
#pragma unroll
          for (int nt = 0; nt < 4; ++nt) xv[nt] = sp[32 * nt];
#pragma unroll
          for (int nt = 0; nt < 4; ++nt) dp[32 * nt] = xv[nt] + gt[nt] * acc[nt][4 * g + j];
          __builtin_amdgcn_sched_barrier(0);
        }
      continue;
    }
    gemm_main<false>(A, W, m0, n0, lds, acc);
    const int m = m0 + 32 * w + l31;
    const bool lat = m0 >= 256;
    const int tl = m - 256;
    const int prow = (tl >> 6) & 255, pcol = tl & 63;
    float scl = 1.f;
    bool do_silu = false;
    bfraw* dbase; size_t dR0, drs, dC0 = 0, dho = 0;
    if (kind == 0) {
      if (tn < 16) {
        const bool isq = tn < 8;
        const int hb = 2 * (isq ? tn : tn - 8);
        dbase = (bfraw*)(P.ws + (isq ? OFF_QA : OFF_KA)); dR0 = (size_t)hb * MT + m0; drs = 64; dho = (size_t)MT * 64 - 64;
        scl = isq ? 0.125f * LOG2E : 1.f;
        if (lat) {
#pragma unroll
          for (int nt = 0; nt < 4; ++nt) {
            const int pos = (nt & 1) ? pcol : prow;
#pragma unroll
            for (int g = 0; g < 2; ++g) {
              const f32x4 c4 = *(const f32x4*)(rope + pos * 16 + 8 * g + 4 * hh);
              const f32x4 s4 = *(const f32x4*)(rope + 4096 + pos * 16 + 8 * g + 4 * hh);
              const float cc[4] = {c4.x, c4.y, c4.z, c4.w}, sn[4] = {s4.x, s4.y, s4.z, s4.w};
#pragma unroll
              for (int j = 0; j < 4; ++j) {
                const float x1 = acc[nt][4 * g + j], x2 = acc[nt][4 * g + j + 8];
                acc[nt][4 * g + j] = x1 * cc[j] - x2 * sn[j];
                acc[nt][4 * g + j + 8] = x1 * sn[j] + x2 * cc[j];
              }
              __builtin_amdgcn_sched_barrier(0);
            }
          }
        }
      } else if (tn < 32 || tn >= 48) {
        do_silu = true;
        dbase = (bfraw*)(P.ws + (tn < 32 ? OFF_GA : OFF_GB)); dR0 = m0; drs = 1024; dC0 = (size_t)((tn < 32 ? tn - 24 : tn - 48) * 128);
      } else if (tn < 36) {
        dbase = (bfraw*)(P.ws + OFF_QB); dR0 = (size_t)(tn - 32) * MT + m0; drs = 128;
      } else {
        const int head = tn - 36;
        scl = 0.08838834764831845f;
        dbase = (bfraw*)(P.ws + OFF_KB); dR0 = (size_t)head * MT + m0; drs = 128;
        bfraw* tp = (bfraw*)(P.ws + OFF_KBT) + (size_t)(head * 128) * MT + perm16(m);
#pragma unroll
        for (int nt = 0; nt < 4; ++nt)
#pragma unroll
          for (int g = 0; g < 4; ++g) {
            const unsigned u0 = pk2(acc[nt][4 * g] * scl, acc[nt][4 * g + 1] * scl);
            const unsigned u1 = pk2(acc[nt][4 * g + 2] * scl, acc[nt][4 * g + 3] * scl);
            const int nl = 32 * nt + 8 * g + 4 * hh;
            tp[(size_t)(nl + 0) * MT] = (bfraw)(u0 & 0xffffu);
            tp[(size_t)(nl + 1) * MT] = (bfraw)(u0 >> 16);
            tp[(size_t)(nl + 2) * MT] = (bfraw)(u1 & 0xffffu);
            tp[(size_t)(nl + 3) * MT] = (bfraw)(u1 >> 16); __builtin_amdgcn_sched_barrier(0);
          }
      }
    } else {
      if (tn < 20) {
        const bool isq = tn < 16;
        const int head = isq ? tn : tn - 16;
        const float* qg = P.qk_norm + eo * 256 + (isq ? 0 : 128);
        dbase = (bfraw*)(P.ws + (isq ? OFF_QC : OFF_KC)); dR0 = (size_t)head * MT + m0; drs = 128;
        scl = isq ? 0.08838834764831845f * LOG2E : 1.f;
        float ss = 0.f;
#pragma unroll
        for (int nt = 0; nt < 4; ++nt)
#pragma unroll
          for (int r = 0; r < 16; ++r) ss += acc[nt][r] * acc[nt][r];
        ss = xsum32(ss);
        const float rstd = rsqrtf(ss * (1.f / 128.f) + EPSN);
#pragma unroll
        for (int nt = 0; nt < 4; ++nt)
#pragma unroll
          for (int g = 0; g < 4; ++g) {
            const f32x4 g4 = *(const f32x4*)(qg + 32 * nt + 8 * g + 4 * hh);
            acc[nt][4 * g] *= rstd * g4.x; acc[nt][4 * g + 1] *= rstd * g4.y;
            acc[nt][4 * g + 2] *= rstd * g4.z; acc[nt][4 * g + 3] *= rstd * g4.w; __builtin_amdgcn_sched_barrier(0);
          }
        if (lat) {
#pragma unroll
          for (int p = 0; p < 2; ++p) {
            const int pos = p ? pcol : prow;
#pragma unroll
            for (int g = 0; g < 4; ++g) {
              const f32x4 c4 = *(const f32x4*)(rope + 8192 + pos * 32 + 8 * g + 4 * hh);
              const f32x4 s4 = *(const f32x4*)(rope + 16384 + pos * 32 + 8 * g + 4 * hh);
              const float cc[4] = {c4.x, c4.y, c4.z, c4.w}, sn[4] = {s4.x, s4.y, s4.z, s4.w};
#pragma unroll
              for (int j = 0; j < 4; ++j) {
                const float x1 = acc[2 * p][4 * g + j], x2 = acc[2 * p + 1][4 * g + j];
                acc[2 * p][4 * g + j] = x1 * cc[j] - x2 * sn[j];
                acc[2 * p + 1][4 * g + j] = x1 * sn[j] + x2 * cc[j];
              }
              __builtin_amdgcn_sched_barrier(0);
            }
          }
        }
      } else {
        do_silu = true;
        dbase = (bfraw*)(P.ws + OFF_GC); dR0 = m0; drs = 2048; dC0 = (size_t)((tn - 24) * 128);
      }
    }
#pragma unroll
    for (int nt = 0; nt < 4; ++nt)
#pragma unroll
      for (int g = 0; g < 4; ++g) {
        float v0 = acc[nt][4 * g], v1 = acc[nt][4 * g + 1], v2 = acc[nt][4 * g + 2], v3 = acc[nt][4 * g + 3];
        if (do_silu) { v0 = siluf(v0); v1 = siluf(v1); v2 = siluf(v2); v3 = siluf(v3); }
        else { v0 *= scl; v1 *= scl; v2 *= scl; v3 *= scl; }
        u32x2 u = {pk2(v0, v1), pk2(v2, v3)};
        pk[nt][g] = u;
      }
    tile_store<false>(lds, pk, dbase, dR0, drs, dC0, dho);
  }
}

template <int D>
DEV void flash_block(const bfraw* Qh, const bfraw* Kh_, const bfraw* Vt_, int q0, int kt0, int nk, bfraw* lds, f32x16 (&O)[4], float& lsum, float& mref, int pmode = 0) {
  const bfraw* Kh = Kh_ + (size_t)kt0 * 64 * D;
  const bfraw* Vt = Vt_ + kt0 * 64;
  constexpr int KS = D + 8;
  constexpr int KT = 64 * KS;
  constexpr int STG = KT + 128 * 72;
  constexpr int KCH = D / 8;
  constexpr int NKC = 64 * KCH / 256;
  const int tid = otid(), lane = tid & 63, w = tid >> 6, l31 = lane & 31, hh = lane >> 5;
  bf16x8 qf[D / 16];
  {
    const bfraw* qp = Qh + (size_t)(q0 + 32 * w + l31) * D + 8 * hh;
#pragma unroll
    for (int s = 0; s < D / 16; ++s) qf[s] = *(const bf16x8*)(qp + 16 * s);
  }
#pragma unroll
  for (int d = 0; d < 4; ++d)
#pragma unroll
    for (int r = 0; r < 16; ++r) O[d][r] = 0.f;
  lsum = 0.f;
  u32x4 rk[NKC], rv[4];
  const int krow = tid / KCH, kcol = (tid % KCH) * 8;
  const int vrow = tid >> 3, vcol = (tid & 7) * 8;
  const unsigned koff = (unsigned)(krow * D + kcol) * 2u, voff = (unsigned)(vrow * MT + vcol) * 2u;
#pragma unroll
  for (int j = 0; j < NKC; ++j) rk[j] = ldg(Kh + (size_t)j * (256 / KCH) * D, koff);
#pragma unroll
  for (int j = 0; j < 4; ++j) rv[j] = ldg(Vt + (size_t)j * 32 * MT, voff);
#pragma unroll
  for (int j = 0; j < NKC; ++j) *(u32x4*)(lds + (krow + j * (256 / KCH)) * KS + kcol) = rk[j];
#pragma unroll
  for (int j = 0; j < 4; ++j) *(u32x4*)(lds + KT + (vrow + 32 * j) * 72 + vcol) = rv[j];
  lds_barrier();
  f32x16 negm;
  {
    f32x16 s0, s1;
#pragma unroll
    for (int r = 0; r < 16; ++r) { s0[r] = 0.f; s1[r] = 0.f; }
#pragma unroll
    for (int s = 0; s < D / 16; ++s) {
      s0 = mfma(*(const bf16x8*)(lds + l31 * KS + 16 * s + 8 * hh), qf[s], s0);
      s1 = mfma(*(const bf16x8*)(lds + (32 + l31) * KS + 16 * s + 8 * hh), qf[s], s1);
    }
    float mx = fmaxf(s0[0], s1[0]);
#pragma unroll
    for (int r = 1; r < 16; ++r) mx = fmaxf(mx, fmaxf(s0[r], s1[r]));
    mx = xmax32(mx);
#pragma unroll
    for (int r = 0; r < 16; ++r) negm[r] = -mx;
  }
  const int ntile = nk >> 6;
  float pm = 0.f;
#pragma unroll 1
  for (int t = 0; t < ntile; ++t) {
    const bfraw* sK = lds + (t & 1) * STG;
    const bfraw* sV = sK + KT;
    if (t + 1 < ntile && !(pmode & 1)) {
      const int key0 = (t + 1) * 64;
#pragma unroll
      for (int j = 0; j < NKC; ++j) rk[j] = ldg(Kh + (size_t)(key0 + j * (256 / KCH)) * D, koff);
#pragma unroll
      for (int j = 0; j < 4; ++j) rv[j] = ldg(Vt + (size_t)j * 32 * MT + key0, voff);
    }
    f32x16 sc[2];
    bf16x8 vf[4];
    pm = 0.f;
    {
      constexpr int NS = D / 16;
      constexpr int SL = 16 / NS;
      const bfraw* k0p = sK + l31 * KS + 8 * hh;
      const bfraw* k1p = sK + (32 + l31) * KS + 8 * hh;
      bf16x8 ka[NS], kb[NS];
      ka[0] = *(const bf16x8*)(k0p);
      ka[1] = *(const bf16x8*)(k0p + 16);
#pragma unroll
      for (int s = 0; s < NS; ++s) {
        if (s + 2 < NS) ka[s + 2] = *(const bf16x8*)(k0p + 16 * (s + 2));
        else kb[s + 2 - NS] = *(const bf16x8*)(k1p + 16 * (s + 2 - NS));
        sc[0] = mfma(ka[s], qf[s], s == 0 ? negm : sc[0]);
      }
      __builtin_amdgcn_sched_group_barrier(0x100, 2, 0);
#pragma unroll
      for (int s = 0; s < NS; ++s) {
        __builtin_amdgcn_sched_group_barrier(0x008, 1, 0);
        __builtin_amdgcn_sched_group_barrier(0x100, 1, 0);
      }
      __builtin_amdgcn_sched_barrier(0);
#pragma unroll
      for (int d = 0; d < 4; ++d) vf[d] = *(const bf16x8*)(sV + (32 * d + l31) * 72 + 8 * hh);
#pragma unroll
      for (int s = 0; s < NS; ++s) {
        if (s + 2 < NS) kb[s + 2] = *(const bf16x8*)(k1p + 16 * (s + 2));
        sc[1] = mfma(kb[s], qf[s], s == 0 ? negm : sc[1]);
#pragma unroll
        for (int r = s * SL; r < (s + 1) * SL; ++r) {
          const float p = fexp2(sc[0][r]);
          sc[0][r] = p;
          lsum += p;
        }
        __builtin_amdgcn_sched_barrier(0);
      }
    }
#pragma unroll
    for (int kt = 0; kt < 2; ++kt) {
#if PROBE_DUP >= 10
      if (pmode & 2) {
#pragma unroll
        for (int r = 0; r < 16; ++r) { sc[kt][r] *= 0.001f; }
      } else
#endif
      if (kt == 1) {
#pragma unroll
      for (int r = 0; r < 16; ++r) {
        const float p = fexp2(sc[kt][r]);
        sc[kt][r] = p;
        lsum += p;
      }
      }
#pragma unroll
      for (int tt = 0; tt < 2; ++tt) {
        const bf16x8 pf = pack8(sc[kt][8 * tt], sc[kt][8 * tt + 1], sc[kt][8 * tt + 2], sc[kt][8 * tt + 3],
                                sc[kt][8 * tt + 4], sc[kt][8 * tt + 5], sc[kt][8 * tt + 6], sc[kt][8 * tt + 7]);
        bf16x8 vn[4];
        if (kt * 2 + tt < 3) {
#pragma unroll
          for (int d = 0; d < 4; ++d) vn[d] = *(const bf16x8*)(sV + (32 * d + l31) * 72 + 16 * (kt * 2 + tt + 1) + 8 * hh);
        }
#if PROBE_DUP >= 10
        if (!(pmode & 4))
#endif
        {
#pragma unroll
        for (int d = 0; d < 4; ++d) O[d] = mfma(vf[d], pf, O[d]);
        }
        if (kt * 2 + tt < 3) {
#pragma unroll
          for (int d = 0; d < 4; ++d) vf[d] = vn[d];
        }
      }
      if ((t & 3) == 3) {
#pragma unroll
        for (int r = 0; r < 16; r += 2) pm = fmaxf(pm, fmaxf(sc[kt][r], sc[kt][r + 1]));
      }
    }
    bool chk = (t & 3) == 3;
    if (chk) { pm = xmax32(pm); chk = __builtin_amdgcn_ballot_w64(pm > 256.f) != 0; }
    if (chk) {
      const bool up = pm > 256.f;
      const float alpha = up ? __builtin_amdgcn_rcpf(pm) : 1.f;
      const float dlt = up ? __builtin_amdgcn_logf(pm) : 0.f;
      lsum *= alpha;
#pragma unroll
      for (int d = 0; d < 4; ++d)
#pragma unroll
        for (int r = 0; r < 16; ++r) O[d][r] *= alpha;
#pragma unroll
      for (int r = 0; r < 16; ++r) negm[r] -= dlt;
    }
    if (t + 1 < ntile && !(pmode & 1)) {
      bfraw* nK = lds + ((t + 1) & 1) * STG;
#pragma unroll
      for (int j = 0; j < NKC; ++j) *(u32x4*)(nK + (krow + j * (256 / KCH)) * KS + kcol) = rk[j];
#pragma unroll
      for (int j = 0; j < 4; ++j) *(u32x4*)(nK + KT + (vrow + 32 * j) * 72 + vcol) = rv[j];
    }
    lds_barrier();
  }
  lsum = xsum32(lsum);
  mref = -negm[0];
}

DEV void chain_item(const Params& P, int e, int it, bfraw* lds) {
  const int tid = otid(), lane = tid & 63, w = tid >> 6, l31 = lane & 31, hh = lane >> 5;
  const int dir = it >> 3, head = (it >> 1) & 3, half = it & 1;
  const float lg2 = -__expf(P.ret_decay[e * 8 + dir * 4 + head]) * LOG2E;
  const float cd = exp2f(lg2 * 64.f);
  bfraw* sQ = lds;
  bfraw* sK = lds + 8704;
  bfraw* sKt = lds + 17408;
  bfraw* sV = lds + 26624;
  const bfraw* Qg = (const bfraw*)(P.ws + OFF_QB) + (size_t)head * MT * 128;
  const bfraw* Kg = (const bfraw*)(P.ws + OFF_KB) + (size_t)head * MT * 128;
  const bfraw* Ktg = (const bfraw*)(P.ws + OFF_KBT) + (size_t)(head * 128) * MT;
  const bfraw* Vg = (const bfraw*)(P.ws + OFF_VTB) + (size_t)(head * 256 + half * 128) * MT;
  float* og = (float*)(P.ws + (dir ? OFF_OB : OFF_OF));
  f32x16 St[4];
  int nrep_c = (PROBE_DUP == 20) ? 2 : 1;
  asm volatile("" : "+s"(nrep_c));
#pragma unroll 1
  for (int rep = 0; rep < nrep_c; ++rep) {
#pragma unroll
  for (int d = 0; d < 4; ++d)
#pragma unroll
    for (int r = 0; r < 16; ++r) St[d][r] = 0.f;
  u32x4 rq[4], rk[4], rkt[4], rv[4];
  const int qrow = tid >> 4, qcol = (tid & 15) * 8;
  const int trow = tid >> 3, tcol = (tid & 7) * 8;
  const unsigned qoff = (unsigned)(qrow * 128 + qcol) * 2u, toff = (unsigned)(trow * MT + tcol) * 2u;
  {
    const int r0 = dir == 0 ? 0 : 192;
#pragma unroll
    for (int j = 0; j < 4; ++j) {
      rkt[j] = ldgu(Ktg + (size_t)(32 * j) * MT + r0, toff);
      rv[j] = ldgu(Vg + (size_t)(32 * j) * MT + r0, toff);
    }
  }
#pragma unroll 1
  for (int n = 0; n < 260; ++n) {
    const int r0 = dir == 0 ? 64 * n : (n < 4 ? 192 - 64 * n : 16576 - 64 * (n - 4));
    const int n1 = n + 1 < 260 ? n + 1 : n;
    const int r1 = dir == 0 ? 64 * n1 : (n1 < 4 ? 192 - 64 * n1 : 16576 - 64 * (n1 - 4));
    float lg2v = lg2;
    int lanev = lane;
    asm volatile("" : "+v"(lg2v), "+v"(lanev));
    const int l31v = lanev & 31, hhv = lanev >> 5;
    lds_barrier();
#pragma unroll
    for (int j = 0; j < 4; ++j) {
      rq[j] = ldgu(Qg + (size_t)(r0 + 16 * j) * 128, qoff);
      rk[j] = ldgu(Kg + (size_t)(r0 + 16 * j) * 128, qoff);
    }
    {
      float kdec[8];
#pragma unroll
      for (int e8 = 0; e8 < 8; ++e8) {
        const int slot = (lanev & 7) * 8 + e8;
        const int orig = perm16(slot);
        kdec[e8] = fexp2(lg2v * (float)(dir == 0 ? 63 - orig : orig));
      }
#pragma unroll
      for (int j = 0; j < 4; ++j) {
        *(u32x4*)(sV + (trow + 32 * j) * 72 + tcol) = rv[j];
        u32x4 u = rkt[j];
        u.x = pk2(bflo(u.x) * kdec[0], bfhi(u.x) * kdec[1]);
        u.y = pk2(bflo(u.y) * kdec[2], bfhi(u.y) * kdec[3]);
        u.z = pk2(bflo(u.z) * kdec[4], bfhi(u.z) * kdec[5]);
        u.w = pk2(bflo(u.w) * kdec[6], bfhi(u.w) * kdec[7]);
        *(u32x4*)(sKt + (trow + 32 * j) * 72 + tcol) = u;
      }
#pragma unroll
      for (int j = 0; j < 4; ++j) {
        *(u32x4*)(sQ + (qrow + 16 * j) * 136 + qcol) = rq[j];
        *(u32x4*)(sK + (qrow + 16 * j) * 136 + qcol) = rk[j];
      }
    }
    lds_barrier();
#pragma unroll
    for (int qt = 0; qt < 2; ++qt) {
      f32x16 O;
#pragma unroll
      for (int r = 0; r < 16; ++r) O[r] = 0.f;
      {
        u32x4 qp8[8];
#pragma unroll
        for (int i = 0; i < 8; ++i) {
          const bfraw* qp = sQ + (32 * qt + l31) * 136 + 16 * i + 4 * hh;
          const u32x2 lo = *(const u32x2*)qp;
          const u32x2 hi = *(const u32x2*)(qp + 8);
          u32x4 u = {lo.x, lo.y, hi.x, hi.y};
          qp8[i] = u;
        }
        __builtin_amdgcn_sched_barrier(0);
#pragma unroll
        for (int dkt = 0; dkt < 4; ++dkt)
#pragma unroll
          for (int tt = 0; tt < 2; ++tt) {
            const bf16x8 af = pack8(St[dkt][8 * tt], St[dkt][8 * tt + 1], St[dkt][8 * tt + 2], St[dkt][8 * tt + 3],
                                    St[dkt][8 * tt + 4], St[dkt][8 * tt + 5], St[dkt][8 * tt + 6], St[dkt][8 * tt + 7]);
            O = mfma(af, __builtin_bit_cast(bf16x8, qp8[dkt * 2 + tt]), O);
          }
      }
      {
        const int offq = 32 * qt + l31v;
        const float qd = fexp2(lg2v * (float)(dir == 0 ? offq + 1 : 64 - offq));
#pragma unroll
        for (int r = 0; r < 16; ++r) O[r] *= qd;
      }
      bf16x8 qf[8];
#pragma unroll
      for (int s = 0; s < 8; ++s) qf[s] = *(const bf16x8*)(sQ + (32 * qt + l31) * 136 + 16 * s + 8 * hh);
#pragma unroll
      for (int kt = 0; kt < 2; ++kt) {
        if (dir == 0 ? (kt <= qt) : (kt >= qt)) {
          bf16x8 kf[8];
#pragma unroll
          for (int s = 0; s < 8; ++s) kf[s] = *(const bf16x8*)(sK + (32 * kt + l31) * 136 + 16 * s + 8 * hh);
          const bf16x8 vf0 = *(const bf16x8*)(sV + (32 * w + l31) * 72 + 32 * kt + 8 * hh);
          const bf16x8 vf1 = *(const bf16x8*)(sV + (32 * w + l31) * 72 + 32 * kt + 16 + 8 * hh);
          __builtin_amdgcn_sched_barrier(0);
          f32x16 sc;
#pragma unroll
          for (int r = 0; r < 16; ++r) sc[r] = 0.f;
#pragma unroll
          for (int s = 0; s < 8; ++s) sc = mfma(kf[s], qf[s], sc);
          const int offq = 32 * qt + l31v;
#pragma unroll
          for (int r = 0; r < 16; ++r) {
            const int offk = 32 * kt + 8 * (r >> 2) + 4 * hhv + (r & 3);
            const int dl = dir == 0 ? offq - offk : offk - offq;
            sc[r] = dl >= 0 ? sc[r] * fexp2(lg2v * (float)dl) : 0.f;
          }
          O = mfma(vf0, pack8(sc[0], sc[1], sc[2], sc[3], sc[4], sc[5], sc[6], sc[7]), O);
          O = mfma(vf1, pack8(sc[8], sc[9], sc[10], sc[11], sc[12], sc[13], sc[14], sc[15]), O);
        }
      }
      float* op = og + (size_t)(r0 + 32 * qt + l31) * 1024 + head * 256 + half * 128 + 32 * w + 4 * hh;
#pragma unroll
      for (int g = 0; g < 4; ++g) {
        f32x4 v = {O[4 * g], O[4 * g + 1], O[4 * g + 2], O[4 * g + 3]};
        *(f32x4*)(op + 8 * g) = v;
      }
    }
    __builtin_amdgcn_sched_barrier(0);
#pragma unroll
    for (int j = 0; j < 4; ++j) {
      rkt[j] = ldgu(Ktg + (size_t)(32 * j) * MT + r1, toff);
      rv[j] = ldgu(Vg + (size_t)(32 * j) * MT + r1, toff);
    }
#pragma unroll
    for (int d = 0; d < 4; ++d)
#pragma unroll
      for (int r = 0; r < 16; ++r) St[d][r] *= cd;
#pragma unroll
    for (int hb = 0; hb < 2; ++hb) {
      bf16x8 vf[2], kf[2][4];
#pragma unroll
      for (int t2 = 0; t2 < 2; ++t2) {
        const int tt = 2 * hb + t2;
        vf[t2] = *(const bf16x8*)(sV + (32 * w + l31) * 72 + 16 * tt + 8 * hh);
#pragma unroll
        for (int dkt = 0; dkt < 4; ++dkt) kf[t2][dkt] = *(const bf16x8*)(sKt + (32 * dkt + l31) * 72 + 16 * tt + 8 * hh);
      }
      __builtin_amdgcn_sched_barrier(0);
#pragma unroll
      for (int t2 = 0; t2 < 2; ++t2)
#pragma unroll
        for (int dkt = 0; dkt < 4; ++dkt) St[dkt] = mfma(kf[t2][dkt], vf[t2], St[dkt]);
    }
  }
  }
  lds_barrier();
}

DEV int next_item(int* ctr, int* s_item) {
  __syncthreads();
  if (otid() == 0) *s_item = atomicAdd(ctr, 1);
  __syncthreads();
  return *s_item;
}

DEV void diff_finish(const Params& P, int e, int layer, int hd, int q0, const f32x16 (&O)[4], float l) {
  int zo = 0;
  asm volatile("" : "+v"(zo));
  const float lambda_init = __builtin_fmaf(-0.6f, __expf(-0.3f * (float)(layer + zo)), 0.8f);
  float s01 = 0.f, s23 = 0.f;
  {
    const float* lp = P.diff_lambda + e * 256 + zo;
    for (int i = 0; i < 64; ++i) { s01 += lp[i] * lp[64 + i]; s23 += lp[128 + i] * lp[192 + i]; }
  }
  const float lam = __expf(s01) - __expf(s23) + lambda_init;
  const float c2 = lam / l;
  float ss = 0.f;
  f32x16 O1[4];
  const float* tmp = (const float*)(P.ws + OFF_DTMP) + (size_t)blockIdx.x * 16384 + (unsigned)otid() * 4u;
#pragma unroll
  for (int d = 0; d < 4; ++d)
#pragma unroll
    for (int g = 0; g < 4; ++g) {
      const f32x4 v = *(const f32x4*)(tmp + (size_t)((d * 4 + g) * 256) * 4);
      const float vv[4] = {v.x, v.y, v.z, v.w};
#pragma unroll
      for (int j = 0; j < 4; ++j) {
        const float o = vv[j] - c2 * O[d][4 * g + j];
        O1[d][4 * g + j] = o;
        ss += o * o;
      }
    }
  ss = xsum32(ss);
  const float rstd = rsqrtf(ss * (1.f / 128.f) + EPSN) * (1.f - lambda_init);
  const int tid = otid(), lane = tid & 63, w = tid >> 6, l31 = lane & 31, hh = lane >> 5;
  const int m = q0 + 32 * w + l31;
  const bfraw* gp = (const bfraw*)(P.ws + OFF_GA) + (size_t)m * 1024 + hd * 128 + 4 * hh;
  bfraw* yp = (bfraw*)(P.ws + OFF_H) + (size_t)m * 2048 + hd * 128 + 4 * hh;
  const float* sg = P.diff_subln + e * 128 + 4 * hh;
#pragma unroll
  for (int d = 0; d < 4; ++d)
#pragma unroll
    for (int g = 0; g < 4; ++g) {
      const f32x4 s4 = *(const f32x4*)(sg + 32 * d + 8 * g);
      const u32x2 gg = *(const u32x2*)(gp + 32 * d + 8 * g);
      const float y0 = O1[d][4 * g] * rstd * s4.x * bflo(gg.x);
      const float y1 = O1[d][4 * g + 1] * rstd * s4.y * bfhi(gg.x);
      const float y2 = O1[d][4 * g + 2] * rstd * s4.z * bflo(gg.y);
      const float y3 = O1[d][4 * g + 3] * rstd * s4.w * bfhi(gg.y);
      u32x2 u = {pk2(y0, y1), pk2(y2, y3)};
      *(u32x2*)(yp + 32 * d + 8 * g) = u; __builtin_amdgcn_sched_barrier(0);
    }
}

constexpr int NSPLIT = 0, KSEG = 10, SEGT = 26;
DEV void phase_attn_even(const Params& P, int layer, unsigned char* smem, int* s_item, int cslot) {
  bfraw* lds = (bfraw*)smem;
  const int e = layer >> 1;
  int* ctr = (int*)(P.ws + OFF_CTR) + layer + cslot;
  const int NCH = 16, NFULL = 8 * 128 - NSPLIT, NSUB = NSPLIT * KSEG, NCX = 8 * 2;
  const int total = NCH + NFULL + NSUB + NCX;
  int itq = next_item(ctr, s_item);
#if PROBE_DUP == 21
  while (itq < NCH) { itq = next_item(ctr, s_item); }
#else
  while (itq < NCH) { chain_item(P, e, itq, lds); itq = next_item(ctr, s_item); }
#endif
  for (;; itq = next_item(ctr, s_item)) {
    if (itq >= total) break;
    int it = itq - NCH;
    int hd, q0, nk, kt0 = 0, sub = -1;
    if (it < NFULL) { hd = it >> 7; q0 = 256 + 128 * (it & 127); nk = MT; }
    else if (it < NFULL + NSUB) {
      sub = it - NFULL;
      const int full = NFULL + sub / KSEG;
      hd = full >> 7; q0 = 256 + 128 * (full & 127); kt0 = (sub % KSEG) * SEGT; nk = SEGT * 64;
    } else { it -= NFULL + NSUB; hd = it >> 1; q0 = 128 * (it & 1); nk = 256; }
    f32x16 O[4];
    float l, mr;
    const bfraw* Vt = (const bfraw*)(P.ws + OFF_VTA) + (size_t)(hd * 128) * MT;
#pragma unroll 1
    for (int a = 0; a < 2; ++a) {
      const bfraw* Qh = (const bfraw*)(P.ws + OFF_QA) + (size_t)(2 * hd + a) * MT * 64;
      const bfraw* Kh = (const bfraw*)(P.ws + OFF_KA) + (size_t)(2 * hd + a) * MT * 64;
      flash_block<64>(Qh, Kh, Vt, q0, kt0, nk, lds, O, l, mr);
      if (sub >= 0) {
        float* pp = (float*)(P.ws + OFF_PART) + (size_t)(sub * 2 + a) * 17 * 1024 + (unsigned)otid() * 4u;
#pragma unroll
        for (int d = 0; d < 4; ++d)
#pragma unroll
          for (int g = 0; g < 4; ++g) {
            f32x4 v = {O[d][4 * g], O[d][4 * g + 1], O[d][4 * g + 2], O[d][4 * g + 3]};
            *(f32x4*)(pp + (size_t)((d * 4 + g) * 1024)) = v;
          }
        f32x4 st = {l, mr, 0.f, 0.f};
        *(f32x4*)(pp + (size_t)16 * 1024) = st;
      } else if (a == 0) {
        const float inv = 1.f / l;
        float* tmp = (float*)(P.ws + OFF_DTMP) + (size_t)blockIdx.x * 16384 + (unsigned)otid() * 4u;
#pragma unroll
        for (int d = 0; d < 4; ++d)
#pragma unroll
          for (int g = 0; g < 4; ++g) {
            f32x4 v = {O[d][4 * g] * inv, O[d][4 * g + 1] * inv, O[d][4 * g + 2] * inv, O[d][4 * g + 3] * inv};
            *(f32x4*)(tmp + (size_t)((d * 4 + g) * 256) * 4) = v;
          }
      }
    }
    if (sub < 0) diff_finish(P, e, layer, hd, q0, O, l);
  }
}

DEV void phase_merge_even(const Params& P, int layer) {
  const int e = layer >> 1;
  for (int j = blockIdx.x; j < NSPLIT; j += gridDim.x) {
    const int full = 8 * 128 - NSPLIT + j;
    const int hd = full >> 7, q0 = 256 + 128 * (full & 127);
    const unsigned to = (unsigned)otid() * 4u;
    f32x16 O[4];
    float l = 1.f;
#pragma unroll 1
    for (int a = 0; a < 2; ++a) {
      const float* pb = (const float*)(P.ws + OFF_PART) + (size_t)(j * KSEG * 2 + a) * 17 * 1024 + to;
      float mmax = -INFINITY;
      for (int sg = 0; sg < KSEG; ++sg) mmax = fmaxf(mmax, (*(const f32x4*)(pb + (size_t)sg * 2 * 17 * 1024 + 16 * 1024)).y);
#pragma unroll
      for (int d = 0; d < 4; ++d)
#pragma unroll
        for (int r = 0; r < 16; ++r) O[d][r] = 0.f;
      float lt = 0.f;
#pragma unroll 1
      for (int sg = 0; sg < KSEG; ++sg) {
        const float* ps = pb + (size_t)sg * 2 * 17 * 1024;
        const f32x4 st = *(const f32x4*)(ps + 16 * 1024);
        const float sc = fexp2(st.y - mmax);
        lt += st.x * sc;
#pragma unroll
        for (int d = 0; d < 4; ++d)
#pragma unroll
          for (int g = 0; g < 4; ++g) {
            const f32x4 v = *(const f32x4*)(ps + (size_t)((d * 4 + g) * 1024));
            O[d][4 * g] += v.x * sc; O[d][4 * g + 1] += v.y * sc; O[d][4 * g + 2] += v.z * sc; O[d][4 * g + 3] += v.w * sc;
          }
      }
      if (a == 0) {
        const float inv = 1.f / lt;
        float* tmp = (float*)(P.ws + OFF_DTMP) + (size_t)blockIdx.x * 16384 + to;
#pragma unroll
        for (int d = 0; d < 4; ++d)
#pragma unroll
          for (int g = 0; g < 4; ++g) {
            f32x4 v = {O[d][4 * g] * inv, O[d][4 * g + 1] * inv, O[d][4 * g + 2] * inv, O[d][4 * g + 3] * inv};
            *(f32x4*)(tmp + (size_t)((d * 4 + g) * 256) * 4) = v;
          }
      } else l = lt;
    }
    diff_finish(P, e, layer, hd, q0, O, l);
  }
}

DEV void phase_attn_odd(const Params& P, int layer, unsigned char* smem, int* s_item, int cslot, int pmode = 0) {
  bfraw* lds = (bfraw*)smem;
  int* ctr = (int*)(P.ws + OFF_CTR) + layer + cslot;
  const int NLAT = 16 * 128, NCX = (layer < 3) ? 16 * 2 : 0;
  const int total = NLAT + NCX;
  for (;;) {
    int it = next_item(ctr, s_item);
    if (it >= total) break;
    int hq, q0, nk;
    if (it < NLAT) { hq = it >> 7; q0 = 256 + 128 * (it & 127); nk = MT; }
    else { it -= NLAT; hq = it >> 1; q0 = 128 * (it & 1); nk = 256; }
    const int kv = hq >> 2;
    f32x16 O[4];
    float l, mr;
    flash_block<128>((const bfraw*)(P.ws + OFF_QC) + (size_t)hq * MT * 128, (const bfraw*)(P.ws + OFF_KC) + (size_t)kv * MT * 128,
                     (const bfraw*)(P.ws + OFF_VTC) + (size_t)(kv * 128) * MT, q0, 0, nk, lds, O, l, mr, pmode);
    if (pmode) { if (l == 12345.678f) ((float*)(P.ws + OFF_DTMP))[0] = O[0][0] + O[1][1] + O[2][2] + O[3][3] + mr; continue; }
    const float inv = 1.f / l;
    const int tid = otid(), lane = tid & 63, w = tid >> 6, l31 = lane & 31, hh = lane >> 5;
    const int m = q0 + 32 * w + l31;
    const bfraw* gp = (const bfraw*)(P.ws + OFF_GC) + (size_t)m * 2048 + hq * 128 + 4 * hh;
    bfraw* yp = (bfraw*)(P.ws + OFF_H) + (size_t)m * 2048 + hq * 128 + 4 * hh;
#pragma unroll
    for (int d = 0; d < 4; ++d)
#pragma unroll
      for (int g = 0; g < 4; ++g) {
        const u32x2 gg = *(const u32x2*)(gp + 32 * d + 8 * g);
        const float y0 = O[d][4 * g] * inv * bflo(gg.x);
        const float y1 = O[d][4 * g + 1] * inv * bfhi(gg.x);
        const float y2 = O[d][4 * g + 2] * inv * bflo(gg.y);
        const float y3 = O[d][4 * g + 3] * inv * bfhi(gg.y);
        u32x2 u = {pk2(y0, y1), pk2(y2, y3)};
        *(u32x2*)(yp + 32 * d + 8 * g) = u; __builtin_amdgcn_sched_barrier(0);
      }
  }
}

DEV void phase_comb(const Params& P, int e) {
  const int tid = otid(), lane = tid & 63, w = tid >> 6;
  const float* OFp = (const float*)(P.ws + OFF_OF);
  const float* OBp = (const float*)(P.ws + OFF_OB);
  const bfraw* GB = (const bfraw*)(P.ws + OFF_GB);
  bfraw* Y = (bfraw*)(P.ws + OFF_H);
  f32x4 g4[4];
#pragma unroll
  for (int h = 0; h < 4; ++h) g4[h] = *(const f32x4*)(P.ret_gn + e * 1024 + h * 256 + lane * 4);
  for (int m = blockIdx.x * 4 + w; m < MT; m += gridDim.x * 4) {
    f32x4 z[4];
    u32x2 gg[4];
#pragma unroll
    for (int h = 0; h < 4; ++h) {
      const size_t o = (size_t)m * 1024 + h * 256 + lane * 4;
      z[h] = *(const f32x4*)(OFp + o) + *(const f32x4*)(OBp + o);
      gg[h] = *(const u32x2*)(GB + o);
    }
    float s1[4];
#pragma unroll
    for (int h = 0; h < 4; ++h) s1[h] = z[h].x + z[h].y + z[h].z + z[h].w;
#pragma unroll
    for (int o = 1; o < 64; o <<= 1)
#pragma unroll
      for (int h = 0; h < 4; ++h) s1[h] += __int_as_float(__builtin_amdgcn_ds_bpermute((lane ^ o) << 2, __float_as_int(s1[h])));
    float s2[4];
#pragma unroll
    for (int h = 0; h < 4; ++h) {
      z[h] -= s1[h] * (1.f / 256.f);
      s2[h] = z[h].x * z[h].x + z[h].y * z[h].y + z[h].z * z[h].z + z[h].w * z[h].w;
    }
#pragma unroll
    for (int o = 1; o < 64; o <<= 1)
#pragma unroll
      for (int h = 0; h < 4; ++h) s2[h] += __int_as_float(__builtin_amdgcn_ds_bpermute((lane ^ o) << 2, __float_as_int(s2[h])));
#pragma unroll
    for (int h = 0; h < 4; ++h) {
      const float rstd = rsqrtf(s2[h] * (1.f / 256.f) + EPSN);
      u32x2 u = {pk2(z[h].x * rstd * g4[h].x * bflo(gg[h].x), z[h].y * rstd * g4[h].y * bfhi(gg[h].x)),
                 pk2(z[h].z * rstd * g4[h].z * bflo(gg[h].y), z[h].w * rstd * g4[h].w * bfhi(gg[h].y))};
      *(u32x2*)(Y + (size_t)m * 2048 + 1024 + h * 256 + lane * 4) = u;
    }
  }
}

DEV void stamp(const Params& P, int i) {
#if PROBE_TSA >= 0
  if (blockIdx.x == 0 && otid() == 0) ((unsigned long long*)(P.ws + OFF_BAR + 14336))[i] = wall_clock64();
#endif
}
__global__ void __launch_bounds__(256, 2) mega(Params P) {
  cg::grid_group grid = cg::this_grid();
  __shared__ __attribute__((aligned(16))) unsigned char smem[73728];
  __shared__ int s_item;
  __shared__ __attribute__((aligned(16))) unsigned xb_words[4];
  if (P.ws == nullptr) grid.sync();
  if (otid() == 0) { xb_words[0] = 0u; xb_words[1] = 0u; xb_words[2] = 0u; xb_words[3] = 0u; }
  __syncthreads();
  const XcdBarrier xb = xcd_barrier_post((unsigned*)(P.ws + OFF_BAR), (volatile LAS unsigned*)xb_words);
  stamp(P, 0);
  {
    int nsy = (PROBE_DUP == 32) ? 16 : 0;
    asm volatile("" : "+s"(nsy));
#pragma unroll 1
    for (int rep = 0; rep < nsy; ++rep) xcd_barrier(xb);
  }
#if PROBE_DUP == 34 || PROBE_DUP == 35
  {
    const f32x4* src = (const f32x4*)P.w_mod;
    const size_t n4 = (size_t)4 * 2048 * 6144 / 4;
    f32x4 acc = {0.f, 0.f, 0.f, 0.f};
    const int npass = (PROBE_DUP == 35) ? 3 : 1;
    for (int pass = 0; pass < npass; ++pass)
    for (size_t i = (size_t)blockIdx.x * 256 + otid(); i < n4; i += (size_t)gridDim.x * 256 * 8) {
#pragma unroll
      for (int u = 0; u < 8; ++u) { const size_t k = i + (size_t)u * gridDim.x * 256; if (k < n4) acc += src[k]; }
    }
    if (acc.x + acc.y + acc.z + acc.w == 1.2345e-30f) ((float*)(P.ws + OFF_DTMP))[0] = acc.x;
    xcd_barrier(xb);
  }
#endif
  {
    int nrep_0 = (PROBE_DUP == 30) ? 2 : 1;
    asm volatile("" : "+s"(nrep_0));
#pragma unroll 1
    for (int rep = 0; rep < nrep_0; ++rep) {
      phase0(P, smem);
      xcd_barrier(xb);
      phase0b(P);
      xcd_barrier(xb);
    }
  }
  stamp(P, 1);
#pragma unroll 1
  for (int layer = 0; layer < 4; ++layer) {
    {
      int nrep_n = (PROBE_DUP == 31) ? 2 : 1;
      asm volatile("" : "+s"(nrep_n));
#pragma unroll 1
      for (int rep = 0; rep < nrep_n; ++rep) {
        phase_norm(P, layer);
#if PROBE_DUP == 33
        for (int r2 = 0; r2 < 8; ++r2) { __syncthreads(); phase_norm(P, layer); }
#endif
        xcd_barrier(xb);
      }
    }
    stamp(P, 2 + 5 * layer);
    int nrep_g = (PROBE_DUP == 2) ? 2 : 1, nrep_a = (PROBE_DUP == 1 || (PROBE_DUP == 3 && !(layer & 1)) || ((PROBE_DUP == 4 || PROBE_DUP >= 10) && (layer & 1))) ? 2 : 1;
    asm volatile("" : "+s"(nrep_g), "+s"(nrep_a));
#pragma unroll 1
    for (int rep = 0; rep < nrep_g; ++rep) {
      phase_gemm(P, layer, layer & 1, smem);
      xcd_barrier(xb);
    }
    stamp(P, 3 + 5 * layer);
#pragma unroll 1
    for (int rep = 0; rep < nrep_a; ++rep) {
      if (layer & 1) phase_attn_odd(P, layer, smem, &s_item, 4 * rep, (PROBE_DUP >= 10 && rep + 1 < nrep_a) ? (PROBE_DUP - 10) | 8 : 0);
      else {
#if PROBE_DUP == 21
        if (blockIdx.x < 16) chain_item(P, layer >> 1, blockIdx.x, (bfraw*)smem);
        xcd_barrier(xb);
#endif
        phase_attn_even(P, layer, smem, &s_item, 4 * rep);
      }
      if (rep + 1 < nrep_a) xcd_barrier(xb);
    }
    if (!(layer & 1)) {
      xcd_barrier(xb);
      stamp(P, 4 + 5 * layer);
      phase_comb(P, layer >> 1);
      phase_merge_even(P, layer);
    }
    xcd_barrier(xb);
    stamp(P, 5 + 5 * layer);
    phase_gemm(P, layer, 2, smem);
    xcd_barrier(xb);
    stamp(P, 6 + 5 * layer);
  }
  phase_final(P);
}

extern "C" void kernel_launch(void* const* d_in, const int* in_sizes, int n_in, void* d_out, int out_size, void* d_ws,
                              size_t ws_size, hipStream_t stream) {
  static int grid_blocks = 0;
  if (grid_blocks == 0) {
    if (n_in != 17 || ws_size < WS_END) {
      fprintf(stderr, "kernel_launch: need 17 inputs and >= %zu bytes of workspace; got %d inputs, %zu bytes\n", (size_t)WS_END, n_in, ws_size);
      grid_blocks = -1;
      return;
    }
    int dev = 0, cus = 0, per_cu = 0;
    hipGetDevice(&dev);
    hipDeviceGetAttribute(&cus, hipDeviceAttributeMultiprocessorCount, dev);
    hipOccupancyMaxActiveBlocksPerMultiprocessor(&per_cu, (const void*)mega, 256, 0);
    if (per_cu > 2) per_cu = 2;
    if (per_cu < 1) per_cu = 1;
    grid_blocks = cus * per_cu;
  }
  if (grid_blocks < 0) return;
  Params p{};
  p.x = (const float*)d_in[0]; p.c = (const float*)d_in[1]; p.ctx = (const float*)d_in[2]; p.c_ctx = (const float*)d_in[3];
  p.norm_g = (const float*)d_in[4]; p.w_mod = (const float*)d_in[5]; p.b_mod = (const float*)d_in[6];
  p.ev_w_in = (const float*)d_in[7]; p.ev_w_out = (const float*)d_in[8]; p.diff_lambda = (const float*)d_in[9];
  p.diff_subln = (const float*)d_in[10]; p.ret_decay = (const float*)d_in[11]; p.ret_gn = (const float*)d_in[12];
  p.od_w_in = (const float*)d_in[13]; p.od_w_out = (const float*)d_in[14]; p.qk_norm = (const float*)d_in[15];
  p.final_norm = (const float*)d_in[16];
  p.out = (float*)d_out; p.ws = (unsigned char*)d_ws;
  (void)hipMemsetAsync((unsigned char*)d_ws + OFF_BAR, 0, 16384, stream);
  void* args[] = {&p};
  hipError_t e = hipLaunchCooperativeKernel((const void*)mega, dim3(grid_blocks), dim3(256), args, 0, stream);
  if (e != hipSuccess) fprintf(stderr, "cooperative launch failed: %s (grid %d)\n", hipGetErrorString(e), grid_blocks);
}
```

```cpp
#include <hip/hip_runtime.h>
#include <hip/hip_cooperative_groups.h>
#include <cstdio>
namespace cg = cooperative_groups;
#ifndef PROBE_DUP
#define PROBE_DUP 0
#endif
#ifndef PROBE_TSA
#define PROBE_TSA -1
#define PROBE_TSB -1
#define PROBE_TSS 1e-5f
#endif

typedef unsigned short bfraw;
typedef __attribute__((ext_vector_type(8))) __bf16 bf16x8;
typedef __attribute__((ext_vector_type(2))) __bf16 bf16x2;
typedef __attribute__((ext_vector_type(2))) float f32x2;
typedef __attribute__((ext_vector_type(16))) float f32x16;
typedef __attribute__((ext_vector_type(4))) float f32x4;
typedef __attribute__((ext_vector_type(4))) unsigned u32x4;
typedef __attribute__((ext_vector_type(2))) unsigned u32x2;

#define DEV static __device__ __forceinline__

constexpr int MT = 16640;
constexpr int DM = 2048;
constexpr float LOG2E = 1.4426950408889634f;
constexpr float EPSN = 1e-6f;

constexpr size_t OFF_WT_EVIN  = 0;
constexpr size_t OFF_WT_EVOUT = OFF_WT_EVIN + (size_t)2 * 7168 * 2048 * 2;
constexpr size_t OFF_WT_ODIN  = OFF_WT_EVOUT + (size_t)2 * 2048 * 2048 * 2;
constexpr size_t OFF_WT_ODOUT = OFF_WT_ODIN + (size_t)2 * 5120 * 2048 * 2;
constexpr size_t OFF_MODPART  = OFF_WT_ODOUT + (size_t)2 * 2048 * 2048 * 2;
constexpr size_t OFF_MODV     = OFF_MODPART + (size_t)16 * 4 * 2 * 6144 * 4;
constexpr size_t OFF_ROPE     = OFF_MODV + (size_t)4 * 2 * 6144 * 4;
constexpr size_t OFF_CTR      = OFF_ROPE + (size_t)(8192 + 16384) * 4;
constexpr size_t OFF_BAR      = OFF_CTR + 256;
constexpr size_t OFF_CTXRES   = OFF_BAR + 16384;
constexpr size_t OFF_H        = OFF_CTXRES + (size_t)256 * 2048 * 4;
constexpr size_t OFF_PROJ     = OFF_H + (size_t)MT * 2048 * 2;
constexpr size_t SZ_A         = (size_t)MT * 1024 * 2;
constexpr size_t SZ_B         = (size_t)MT * 512 * 2;
constexpr size_t OFF_QA  = OFF_PROJ;
constexpr size_t OFF_KA  = OFF_QA + SZ_A;
constexpr size_t OFF_VTA = OFF_KA + SZ_A;
constexpr size_t OFF_GA  = OFF_VTA + SZ_A;
constexpr size_t OFF_QB  = OFF_GA + SZ_A;
constexpr size_t OFF_KB  = OFF_QB + SZ_B;
constexpr size_t OFF_KBT = OFF_KB + SZ_B;
constexpr size_t OFF_VTB = OFF_KBT + SZ_B;
constexpr size_t OFF_GB  = OFF_VTB + SZ_A;
constexpr size_t OFF_PROJ_END = OFF_GB + SZ_A;
constexpr size_t OFF_QC  = OFF_PROJ;
constexpr size_t OFF_KC  = OFF_QC + 2 * SZ_A;
constexpr size_t OFF_VTC = OFF_KC + SZ_B;
constexpr size_t OFF_GC  = OFF_VTC + SZ_B;
constexpr size_t OFF_OF  = OFF_PROJ_END;
constexpr size_t OFF_OB  = OFF_OF + (size_t)MT * 1024 * 4;
constexpr size_t OFF_DTMP = OFF_OB + (size_t)MT * 1024 * 4;
constexpr size_t OFF_PART = OFF_DTMP + (size_t)512 * 256 * 64 * 4;
constexpr size_t WS_END  = OFF_PART + (size_t)16 * 10 * 2 * 17 * 1024 * 4;

struct Params {
  const float *x, *c, *ctx, *c_ctx, *norm_g, *w_mod, *b_mod, *ev_w_in, *ev_w_out, *diff_lambda, *diff_subln,
      *ret_decay, *ret_gn, *od_w_in, *od_w_out, *qk_norm, *final_norm;
  float* out;
  unsigned char* ws;
};

DEV f32x16 mfma(bf16x8 a, bf16x8 b, f32x16 c) { return __builtin_amdgcn_mfma_f32_32x32x16_bf16(a, b, c, 0, 0, 0); }
DEV unsigned pk2(float a, float b) {
  f32x2 v = {a, b};
  bf16x2 r = __builtin_convertvector(v, bf16x2);
  return __builtin_bit_cast(unsigned, r);
}
DEV u32x4 ldg(const bfraw* ubase, unsigned voff) { return *(const u32x4*)((const char*)ubase + voff); }
DEV u32x4 ldgu(const bfraw* ubase, unsigned voff) {
  const unsigned long long b = (unsigned long long)ubase;
  const unsigned lo = __builtin_amdgcn_readfirstlane((unsigned)b), hi = __builtin_amdgcn_readfirstlane((unsigned)(b >> 32));
  const char* sb = (const char*)(((unsigned long long)hi << 32) | lo);
  return *(const u32x4*)(sb + voff);
}
DEV int otid() {
  const int wv = __builtin_amdgcn_readfirstlane((int)threadIdx.x >> 6);
  int t = wv * 64 + (int)__builtin_amdgcn_mbcnt_hi(~0u, __builtin_amdgcn_mbcnt_lo(~0u, 0u));
  asm volatile("" : "+v"(t));
  return t;
}
DEV float bflo(unsigned u) { return __uint_as_float(u << 16); }
DEV float bfhi(unsigned u) { return __uint_as_float(u & 0xffff0000u); }
DEV bf16x8 pack8(float a0, float a1, float a2, float a3, float a4, float a5, float a6, float a7) {
  u32x4 u = {pk2(a0, a1), pk2(a2, a3), pk2(a4, a5), pk2(a6, a7)};
  return __builtin_bit_cast(bf16x8, u);
}
DEV bfraw f2bf(float a) { return (bfraw)(pk2(a, 0.f) & 0xffffu); }
DEV float fexp2(float x) { return __builtin_amdgcn_exp2f(x); }
DEV float wave_sum(float v, int lane) {
#pragma unroll
  for (int o = 1; o < 64; o <<= 1) v += __int_as_float(__builtin_amdgcn_ds_bpermute((lane ^ o) << 2, __float_as_int(v)));
  return v;
}
DEV float xsum32(float x) {
  const u32x2 r = __builtin_amdgcn_permlane32_swap(__float_as_uint(x), __float_as_uint(x), false, false);
  return __uint_as_float(r.x) + __uint_as_float(r.y);
}
DEV float xmax32(float x) {
  const u32x2 r = __builtin_amdgcn_permlane32_swap(__float_as_uint(x), __float_as_uint(x), false, false);
  return fmaxf(__uint_as_float(r.x), __uint_as_float(r.y));
}
DEV float uni(float x) { return __int_as_float(__builtin_amdgcn_readfirstlane(__float_as_int(x))); }
DEV float siluf(float v) { return v / (1.f + __expf(-v)); }
DEV void lds_barrier() { asm volatile("s_waitcnt lgkmcnt(0)\n\ts_barrier" ::: "memory"); }
DEV int perm16(int m) {
  int b = (m >> 2) & 3;
  int b2 = ((b & 1) << 1) | (b >> 1);
  return (m & ~12) | (b2 << 2);
}

DEV const float* res_src(const Params& P, int layer, int row) {
  if (row < 256) return (layer == 0 ? P.ctx : (const float*)(P.ws + OFF_CTXRES)) + (size_t)row * DM;
  return (layer == 0 ? P.x : (const float*)P.out) + (size_t)(row - 256) * DM;
}
DEV float* res_dst(const Params& P, int row) {
  if (row < 256) return (float*)(P.ws + OFF_CTXRES) + (size_t)row * DM;
  return P.out + (size_t)(row - 256) * DM;
}

#define XB_TMO      128
#define XB_XCNT(j)  (256  + 64 * (j))
#define XB_XSUB(j)  (1280 + 64 * (j))
#define XB_XGEN(j)  (2304 + 64 * (j))
#define XB_TOP      3328
#define XB_TOPGEN   3392
#define XCD_BAR_WORDS 3456
#define XB_SPIN_CAP (1u << 22)
#define LAS __attribute__((address_space(3)))
DEV unsigned xb_ld(unsigned* p) { return __hip_atomic_load(p, __ATOMIC_RELAXED, __HIP_MEMORY_SCOPE_AGENT); }
DEV unsigned xb_add(unsigned* p, unsigned v) { return __hip_atomic_fetch_add(p, v, __ATOMIC_RELAXED, __HIP_MEMORY_SCOPE_AGENT); }
DEV unsigned xb_xcc_id() { return (unsigned)__builtin_amdgcn_s_getreg((3 << 11) | 20) & 0xFu; }
#define XB_SPIN(cond, bar) do { unsigned _sp = 0; while (cond) { __builtin_amdgcn_s_sleep(1); \
    if ((++_sp & 255u) == 0u) { if (xb_ld(&(bar)[XB_TMO])) break; if (_sp > XB_SPIN_CAP) { atomicAdd(&(bar)[XB_TMO], 1u); break; } } } } while (0)
struct XcdBarrier { unsigned* bar; unsigned x; volatile LAS unsigned* st; };
DEV XcdBarrier xcd_barrier_post(unsigned* bar, volatile LAS unsigned* st) {
  XcdBarrier b; b.bar = bar; b.x = xb_xcc_id(); b.st = st;
  if (otid() == 0) (void)xb_add(&bar[XB_XCNT(b.x)], 1u);
  return b;
}
DEV void xcd_barrier_complete(unsigned* bar, unsigned x, unsigned& nloc, unsigned& nx) {
  const unsigned G = gridDim.x;
  unsigned sum, cnt, mine, sp = 0u;
  for (;;) {
    sum = 0u; cnt = 0u; mine = 0u;
#pragma unroll
    for (unsigned j = 0; j < 16; ++j) { const unsigned c = xb_ld(&bar[XB_XCNT(j)]); sum += c; cnt += (c > 0u) ? 1u : 0u; mine = (j == x) ? c : mine; }
    if (sum == G) break;
    __builtin_amdgcn_s_sleep(1);
    if ((++sp & 255u) == 0u) { if (xb_ld(&bar[XB_TMO])) break; if (sp > XB_SPIN_CAP) { atomicAdd(&bar[XB_TMO], 1u); break; } }
  }
  nloc = mine > 0u ? mine : 1u; nx = cnt > 0u ? cnt : 1u;
}
DEV void xcd_barrier(const XcdBarrier& b) {
  asm volatile("s_waitcnt vmcnt(0)" ::: "memory");
  __syncthreads();
  if (otid() == 0) {
    unsigned* bar = b.bar;
    __builtin_amdgcn_s_waitcnt(0);
    unsigned nloc = b.st[0], nx = b.st[1];
    if (nloc == 0u) { xcd_barrier_complete(bar, b.x, nloc, nx); b.st[0] = nloc; b.st[1] = nx; }
    const unsigned old = xb_add(&bar[XB_XSUB(b.x)], 1u);
    const unsigned gen = old / nloc;
    if (old + 1u == (gen + 1u) * nloc) {
      __builtin_amdgcn_fence(__ATOMIC_RELEASE, "agent");
      asm volatile("s_waitcnt vmcnt(0)" ::: "memory");
      const unsigned og = xb_add(&bar[XB_TOP], 1u);
      const unsigned tg = og / nx;
      if (og + 1u == (tg + 1u) * nx) xb_add(&bar[XB_TOPGEN], 1u);
      else XB_SPIN(xb_ld(&bar[XB_TOPGEN]) == tg, bar);
      __builtin_amdgcn_fence(__ATOMIC_ACQUIRE, "agent");
      xb_add(&bar[XB_XGEN(b.x)], 1u);
      asm volatile("s_waitcnt vmcnt(0)" ::: "memory");
    } else {
      XB_SPIN(xb_ld(&bar[XB_XGEN(b.x)]) == gen, bar);
      __builtin_amdgcn_fence(__ATOMIC_ACQUIRE, "agent");
      asm volatile("s_waitcnt vmcnt(0)" ::: "memory");
    }
  }
  __syncthreads();
}


DEV void phase0(const Params& P, unsigned char* smem) {
  const int tid = otid();
  const int gtid = blockIdx.x * 256 + tid, gsz = gridDim.x * 256;
  if (gtid < 16) ((int*)(P.ws + OFF_CTR))[gtid] = 0;
  float* rope = (float*)(P.ws + OFF_ROPE);
  for (int i = gtid; i < 4096 + 8192; i += gsz) {
    int pos, f; float inv; float *pc, *ps;
    if (i < 4096) { pos = i >> 4; f = i & 15; inv = exp2f(-(float)f * (13.287712379549449f / 16.f)); pc = rope + i; ps = rope + 4096 + i; }
    else { int j = i - 4096; pos = j >> 5; f = j & 31; inv = exp2f(-(float)f * (13.287712379549449f / 32.f)); pc = rope + 8192 + j; ps = rope + 16384 + j; }
    float ang = (float)pos * inv;
    double a = (double)ang;
    double kk = rint(a * 0.15915494309189535);
    float r = (float)(a - kk * 6.283185307179586);
    *pc = __cosf(r); *ps = __sinf(r);
  }
  const int NG = 4 * 16 * 6, NTT = 16384;
  for (int it = blockIdx.x; it < NG + NTT; it += gridDim.x) {
    if (it < NG) {
      const int layer = it / 96, rem = it % 96, kc = rem / 6, ng = rem % 6;
      const int n = ng * 1024 + tid * 4;
      const float* W = P.w_mod + ((size_t)layer * 2048 + kc * 128) * 6144 + n;
      f32x4 al = {0.f, 0.f, 0.f, 0.f}, ac = {0.f, 0.f, 0.f, 0.f};
#pragma unroll 8
      for (int k = 0; k < 128; ++k) {
        const float cl = P.c[kc * 128 + k], cc = P.c_ctx[kc * 128 + k];
        const float sl = siluf(cl), sx = siluf(cc);
        const f32x4 w4 = *(const f32x4*)(W + (size_t)k * 6144);
        al.x += sl * w4.x; al.y += sl * w4.y; al.z += sl * w4.z; al.w += sl * w4.w;
        ac.x += sx * w4.x; ac.y += sx * w4.y; ac.z += sx * w4.z; ac.w += sx * w4.w;
      }
      float* part = (float*)(P.ws + OFF_MODPART) + ((size_t)(kc * 4 + layer) * 2) * 6144;
      *(f32x4*)(part + n) = al;
      *(f32x4*)(part + 6144 + n) = ac;
    } else {
      int t = it - NG;
      const float* src; bfraw* dst; int N;
      if (t < 7168) { int l = t / 3584; t -= l * 3584; N = 7168; src = P.ev_w_in + (size_t)l * 2048 * 7168; dst = (bfraw*)(P.ws + OFF_WT_EVIN) + (size_t)l * 7168 * 2048; }
      else if (t < 7168 + 2048) { t -= 7168; int l = t / 1024; t -= l * 1024; N = 2048; src = P.ev_w_out + (size_t)l * 2048 * 2048; dst = (bfraw*)(P.ws + OFF_WT_EVOUT) + (size_t)l * 2048 * 2048; }
      else if (t < 7168 + 2048 + 5120) { t -= 9216; int l = t / 2560; t -= l * 2560; N = 5120; src = P.od_w_in + (size_t)l * 2048 * 5120; dst = (bfraw*)(P.ws + OFF_WT_ODIN) + (size_t)l * 5120 * 2048; }
      else { t -= 14336; int l = t / 1024; t -= l * 1024; N = 2048; src = P.od_w_out + (size_t)l * 2048 * 2048; dst = (bfraw*)(P.ws + OFF_WT_ODOUT) + (size_t)l * 2048 * 2048; }
      const int ntn = N >> 6;
      const int ntile = t % ntn, ktile = t / ntn;
      float* sT = (float*)smem;
#pragma unroll
      for (int j = 0; j < 4; ++j) {
        const int idx = tid + 256 * j, krow = idx >> 4, c4 = idx & 15;
        const f32x4 v = *(const f32x4*)(src + (size_t)(ktile * 64 + krow) * N + ntile * 64 + c4 * 4);
        float* d = sT + krow * 65 + c4 * 4;
        d[0] = v.x; d[1] = v.y; d[2] = v.z; d[3] = v.w;
      }
      __syncthreads();
#pragma unroll
      for (int j = 0; j < 2; ++j) {
        const int idx = tid + 256 * j, kg = idx & 7, n = idx >> 3;
        const float* s = sT + (kg * 8) * 65 + n;
        u32x4 u = {pk2(s[0], s[65]), pk2(s[130], s[195]), pk2(s[260], s[325]), pk2(s[390], s[455])};
        *(u32x4*)(dst + (size_t)(ntile * 64 + n) * 2048 + ktile * 64 + kg * 8) = u;
      }
      __syncthreads();
    }
  }
}

DEV void phase0b(const Params& P) {
  const int gtid = blockIdx.x * 256 + otid(), gsz = gridDim.x * 256;
  const float* part = (const float*)(P.ws + OFF_MODPART);
  float* modv = (float*)(P.ws + OFF_MODV);
  for (int i = gtid; i < 4 * 2 * 6144; i += gsz) {
    const int layer = i / 12288, rem = i % 12288, which = rem / 6144, n = rem % 6144;
    float s = P.b_mod[layer * 6144 + n];
#pragma unroll
    for (int kc = 0; kc < 16; ++kc) s += part[((size_t)(kc * 4 + layer) * 2 + which) * 6144 + n];
    modv[i] = s;
  }
}

DEV void phase_norm(const Params& P, int layer) {
  const int tid = otid(), lane = tid & 63, w = tid >> 6;
  const float* g = P.norm_g + layer * 2048;
  const float* modv = (const float*)(P.ws + OFF_MODV) + (size_t)layer * 2 * 6144;
  bfraw* H = (bfraw*)(P.ws + OFF_H);
  const int gw = blockIdx.x * 4 + w, nw = gridDim.x * 4;
#pragma unroll 1
  for (int kind = 0; kind < 2; ++kind) {
    const int rbeg = kind ? 256 : 0, rend = kind ? MT : 256;
    const float* mv = modv + (kind ? 0 : 6144);
    int row = rbeg + gw;
    if (row >= rend) continue;
    f32x4 mul[8], add[8];
#pragma unroll
    for (int it = 0; it < 8; ++it) {
      const int c = (it * 64 + lane) * 4;
      const f32x4 g4 = *(const f32x4*)(g + c);
      const f32x4 sc = *(const f32x4*)(mv + 2048 + c);
      add[it] = *(const f32x4*)(mv + c);
      mul[it] = g4 * (1.f + sc);
    }
    f32x4 v[8];
    {
      const float* src = res_src(P, layer, row);
#pragma unroll
      for (int it = 0; it < 8; ++it) v[it] = *(const f32x4*)(src + (it * 64 + lane) * 4);
    }
#pragma unroll 1
    for (; row < rend; row += nw) {
      f32x4 nv[8];
      const int nrow = row + nw < rend ? row + nw : row;
      {
        const float* src = res_src(P, layer, nrow);
#pragma unroll
        for (int it = 0; it < 8; ++it) nv[it] = *(const f32x4*)(src + (it * 64 + lane) * 4);
      }
      float ss = 0.f;
#pragma unroll
      for (int it = 0; it < 8; ++it) ss += v[it].x * v[it].x + v[it].y * v[it].y + v[it].z * v[it].z + v[it].w * v[it].w;
      ss = wave_sum(ss, lane);
      const float rstd = rsqrtf(ss * (1.f / 2048.f) + EPSN);
#pragma unroll
      for (int it = 0; it < 8; ++it) {
        const int c = (it * 64 + lane) * 4;
        const f32x4 y = v[it] * rstd * mul[it] + add[it];
        u32x2 u = {pk2(y.x, y.y), pk2(y.z, y.w)};
        *(u32x2*)(H + (size_t)row * 2048 + c) = u;
      }
#pragma unroll
      for (int it = 0; it < 8; ++it) v[it] = nv[it];
    }
  }
}

DEV void phase_final(const Params& P) {
  const int tid = otid(), lane = tid & 63, w = tid >> 6;
  const int gw = blockIdx.x * 4 + w, nw = gridDim.x * 4;
  f32x4 g4[8];
#pragma unroll
  for (int it = 0; it < 8; ++it) g4[it] = *(const f32x4*)(P.final_norm + (it * 64 + lane) * 4);
  int row = gw;
  if (row >= 16384) return;
  f32x4 v[8];
#pragma unroll
  for (int it = 0; it < 8; ++it) v[it] = *(const f32x4*)(P.out + (size_t)row * DM + (it * 64 + lane) * 4);
#pragma unroll 1
  for (; row < 16384; row += nw) {
    f32x4 nv[8];
    const int nrow = row + nw < 16384 ? row + nw : row;
#pragma unroll
    for (int it = 0; it < 8; ++it) nv[it] = *(const f32x4*)(P.out + (size_t)nrow * DM + (it * 64 + lane) * 4);
    float* src = P.out + (size_t)row * DM;
    float ss = 0.f;
#pragma unroll
    for (int it = 0; it < 8; ++it) ss += v[it].x * v[it].x + v[it].y * v[it].y + v[it].z * v[it].z + v[it].w * v[it].w;
    ss = wave_sum(ss, lane);
    const float rstd = rsqrtf(ss * (1.f / 2048.f) + EPSN);
#pragma unroll
    for (int it = 0; it < 8; ++it) {
      const int c = (it * 64 + lane) * 4;
      f32x4 y = v[it] * rstd * g4[it];
#if PROBE_TSA >= 0
      {
        const unsigned long long* ts = (const unsigned long long*)(P.ws + OFF_BAR + 14336);
        const float us = (float)(long long)(ts[PROBE_TSB] - ts[PROBE_TSA]) * 0.01f;
        y *= (1.f + PROBE_TSS * us);
      }
#endif
      *(f32x4*)(src + c) = y;
    }
#pragma unroll
    for (int it = 0; it < 8; ++it) v[it] = nv[it];
  }
}

template <bool FEAT>
DEV void gemm_step(const bfraw* cA, const bfraw* cB, int w, int l31, int hh, f32x16 (&acc)[4]) {
  const bfraw* pm = cA + (32 * w + l31) * 72 + hh * 8;
  const bfraw* pn = cB + l31 * 72 + hh * 8;
  bf16x8 fm[4], fn[4][4];
  fm[0] = *(const bf16x8*)pm;
#pragma unroll
  for (int nt = 0; nt < 4; ++nt) fn[0][nt] = *(const bf16x8*)(pn + 32 * nt * 72);
#pragma unroll
  for (int s = 0; s < 4; ++s) {
    if (s < 3) {
      fm[s + 1] = *(const bf16x8*)(pm + (s + 1) * 16);
#pragma unroll
      for (int nt = 0; nt < 4; ++nt) fn[s + 1][nt] = *(const bf16x8*)(pn + 32 * nt * 72 + (s + 1) * 16);
    }
#pragma unroll
    for (int nt = 0; nt < 4; ++nt) {
      if (FEAT) acc[nt] = mfma(fm[s], fn[s][nt], acc[nt]);
      else acc[nt] = mfma(fn[s][nt], fm[s], acc[nt]);
    }
  }
  __builtin_amdgcn_sched_group_barrier(0x100, 5, 0);
#pragma unroll
  for (int s = 0; s < 3; ++s) {
    __builtin_amdgcn_sched_group_barrier(0x008, 1, 0);
    __builtin_amdgcn_sched_group_barrier(0x100, 2, 0);
    __builtin_amdgcn_sched_group_barrier(0x008, 1, 0);
    __builtin_amdgcn_sched_group_barrier(0x100, 1, 0);
    __builtin_amdgcn_sched_group_barrier(0x008, 1, 0);
    __builtin_amdgcn_sched_group_barrier(0x100, 1, 0);
    __builtin_amdgcn_sched_group_barrier(0x008, 1, 0);
    __builtin_amdgcn_sched_group_barrier(0x100, 1, 0);
  }
  __builtin_amdgcn_sched_group_barrier(0x008, 4, 0);
}

template <bool FEAT>
DEV void gemm_main(const bfraw* A, const bfraw* W, int m0, int n0, bfraw* lds, f32x16 (&acc)[4]) {
  const int tid = otid(), lane = tid & 63, w = tid >> 6, l31 = lane & 31, hh = lane >> 5;
  const int srow = tid >> 3, scol = (tid & 7) * 8;
  const bfraw* ap = A + (size_t)m0 * 2048;
  const bfraw* wp = W + (size_t)n0 * 2048;
  const unsigned goff = (unsigned)(srow * 2048 + scol) * 2u;
  u32x4 ra0[4], rw0[4], ra1[4], rw1[4];
#pragma unroll
  for (int j = 0; j < 4; ++j) {
    ra0[j] = ldg(ap + (size_t)j * 32 * 2048, goff);
    rw0[j] = ldg(wp + (size_t)j * 32 * 2048, goff);
  }
#pragma unroll
  for (int j = 0; j < 4; ++j) {
    ra1[j] = ldg(ap + (size_t)j * 32 * 2048 + 64, goff);
    rw1[j] = ldg(wp + (size_t)j * 32 * 2048 + 64, goff);
  }
#pragma unroll
  for (int nt = 0; nt < 4; ++nt)
#pragma unroll
    for (int r = 0; r < 16; ++r) acc[nt][r] = 0.f;
#pragma unroll
  for (int j = 0; j < 4; ++j) {
    *(u32x4*)(lds + (srow + 32 * j) * 72 + scol) = ra0[j];
    *(u32x4*)(lds + 9216 + (srow + 32 * j) * 72 + scol) = rw0[j];
  }
#pragma unroll
  for (int j = 0; j < 4; ++j) {
    ra0[j] = ldg(ap + (size_t)j * 32 * 2048 + 128, goff);
    rw0[j] = ldg(wp + (size_t)j * 32 * 2048 + 128, goff);
  }
  lds_barrier();
#pragma unroll 1
  for (int kt = 0; kt < 32; kt += 2) {
    gemm_step<FEAT>(lds, lds + 9216, w, l31, hh, acc);
#pragma unroll
    for (int j = 0; j < 4; ++j) {
      *(u32x4*)(lds + 18432 + (srow + 32 * j) * 72 + scol) = ra1[j];
      *(u32x4*)(lds + 18432 + 9216 + (srow + 32 * j) * 72 + scol) = rw1[j];
    }
    if (kt + 3 < 32) {
#pragma unroll
      for (int j = 0; j < 4; ++j) {
        ra1[j] = ldg(ap + (size_t)j * 32 * 2048 + (kt + 3) * 64, goff);
        rw1[j] = ldg(wp + (size_t)j * 32 * 2048 + (kt + 3) * 64, goff);
      }
    }
    lds_barrier();
    gemm_step<FEAT>(lds + 18432, lds + 18432 + 9216, w, l31, hh, acc);
    if (kt + 2 < 32) {
#pragma unroll
      for (int j = 0; j < 4; ++j) {
        *(u32x4*)(lds + (srow + 32 * j) * 72 + scol) = ra0[j];
        *(u32x4*)(lds + 9216 + (srow + 32 * j) * 72 + scol) = rw0[j];
      }
    }
    if (kt + 4 < 32) {
#pragma unroll
      for (int j = 0; j < 4; ++j) {
        ra0[j] = ldg(ap + (size_t)j * 32 * 2048 + (kt + 4) * 64, goff);
        rw0[j] = ldg(wp + (size_t)j * 32 * 2048 + (kt + 4) * 64, goff);
      }
    }
    lds_barrier();
  }
}

template <bool FEAT>
DEV void tile_store(bfraw* lds, const u32x2 (&pk)[4][4], bfraw* base, size_t R0, size_t rstride, size_t C0, size_t hoff) {
  const int tid = otid(), lane = tid & 63, w = tid >> 6, l31 = lane & 31, hh = lane >> 5;
#pragma unroll
  for (int nt = 0; nt < 4; ++nt)
#pragma unroll
    for (int g = 0; g < 4; ++g) {
      const int row = FEAT ? 32 * nt + l31 : 32 * w + l31;
      const int col = FEAT ? 32 * w + 16 * (g >> 1) + 8 * hh + 4 * (g & 1) : 32 * nt + 8 * g + 4 * hh;
      *(u32x2*)(lds + row * 136 + col) = pk[nt][g];
    }
  lds_barrier();
#pragma unroll
  for (int j = 0; j < 8; ++j) {
    const int c = tid + 256 * j, row = c >> 4, cc = c & 15;
    const u32x4 v = *(const u32x4*)(lds + row * 136 + cc * 8);
    *(u32x4*)(base + (R0 + row) * rstride + C0 + cc * 8 + (size_t)(cc >> 3) * hoff) = v;
  }
  lds_barrier();
}

DEV void phase_gemm(const Params& P, int layer, int kind, unsigned char* smem) {
  const int tid = otid(), lane = tid & 63, w = tid >> 6, l31 = lane & 31, hh = lane >> 5;
  bfraw* lds = (bfraw*)smem;
  const int eo = layer >> 1;
  const bfraw* A = (const bfraw*)(P.ws + OFF_H);
  const bfraw* W;
  int NTN, mt0 = 0;
  if (kind == 0) { W = (const bfraw*)(P.ws + OFF_WT_EVIN) + (size_t)eo * 7168 * 2048; NTN = 56; }
  else if (kind == 1) { W = (const bfraw*)(P.ws + OFF_WT_ODIN) + (size_t)eo * 5120 * 2048; NTN = 40; }
  else { W = (const bfraw*)(P.ws + ((layer & 1) ? OFF_WT_ODOUT : OFF_WT_EVOUT)) + (size_t)eo * 2048 * 2048; NTN = 16; if (layer == 3) mt0 = 2; }
  const float* rope = (const float*)(P.ws + OFF_ROPE);
  const int ntiles = (130 - mt0) * NTN;
  for (int t = blockIdx.x; t < ntiles; t += gridDim.x) {
    const int mt = mt0 + t / NTN, tn = t % NTN;
    const int m0 = mt * 128, n0 = tn * 128;
    f32x16 acc[4];
    u32x2 pk[4][4];
    int vcol = -1; bfraw* vdst = nullptr;
    if (kind == 0) {
      if (tn >= 16 && tn < 24) { vcol = (tn - 16) * 128; vdst = (bfraw*)(P.ws + OFF_VTA); }
      else if (tn >= 40 && tn < 48) { vcol = (tn - 40) * 128; vdst = (bfraw*)(P.ws + OFF_VTB); }
    } else if (kind == 1) {
      if (tn >= 20 && tn < 24) { vcol = (tn - 20) * 128; vdst = (bfraw*)(P.ws + OFF_VTC); }
    }
    if (vcol >= 0) {
      gemm_main<true>(A, W, m0, n0, lds, acc);
#pragma unroll
      for (int nt = 0; nt < 4; ++nt)
#pragma unroll
        for (int g = 0; g < 4; ++g) {
          u32x2 u = {pk2(acc[nt][4 * g], acc[nt][4 * g + 1]), pk2(acc[nt][4 * g + 2], acc[nt][4 * g + 3])};
          pk[nt][g] = u;
        }
      tile_store<true>(lds, pk, vdst, (size_t)vcol, (size_t)MT, (size_t)m0, 0);
      continue;
    }
    if (kind == 2) {
      gemm_main<true>(A, W, m0, n0, lds, acc);
      const bool latr = m0 >= 256;
      const float* gate = (const float*)(P.ws + OFF_MODV) + ((size_t)layer * 2 + (latr ? 0 : 1)) * 6144 + 4096 + n0 + l31;
      float gt[4];
#pragma unroll
      for (int nt = 0; nt < 4; ++nt) gt[nt] = gate[32 * nt];
#pragma unroll
      for (int g = 0; g < 4; ++g)
#pragma unroll
        for (int j = 0; j < 4; ++j) {
          const int mr = m0 + 32 * w + 8 * g + 4 * hh + j;
          const float* sp = res_src(P, layer, mr) + n0 + l31;
          float* dp = res_dst(P, mr) + n0 + l31;
          float xv[4];
#pragma unroll
          for (int nt = 0; nt < 4; ++nt) xv[nt] = sp[32 * nt];
#pragma unroll
          for (int nt = 0; nt < 4; ++nt) dp[32 * nt] = xv[nt] + gt[nt] * acc[nt][4 * g + j];
          __builtin_amdgcn_sched_barrier(0);
        }
      continue;
    }
    gemm_main<false>(A, W, m0, n0, lds, acc);
    const int m = m0 + 32 * w + l31;
    const bool lat = m0 >= 256;
    const int tl = m - 256;
    const int prow = (tl >> 6) & 255, pcol = tl & 63;
    float scl = 1.f;
    bool do_silu = false;
    bfraw* dbase; size_t dR0, drs, dC0 = 0, dho = 0;
    if (kind == 0) {
      if (tn < 16) {
        const bool isq = tn < 8;
        const int hb = 2 * (isq ? tn : tn - 8);
        dbase = (bfraw*)(P.ws + (isq ? OFF_QA : OFF_KA)); dR0 = (size_t)hb * MT + m0; drs = 64; dho = (size_t)MT * 64 - 64;
        scl = isq ? 0.125f * LOG2E : 1.f;
        if (lat) {
#pragma unroll
          for (int nt = 0; nt < 4; ++nt) {
            const int pos = (nt & 1) ? pcol : prow;
#pragma unroll
            for (int g = 0; g < 2; ++g) {
              const f32x4 c4 = *(const f32x4*)(rope + pos * 16 + 8 * g + 4 * hh);
              const f32x4 s4 = *(const f32x4*)(rope + 4096 + pos * 16 + 8 * g + 4 * hh);
              const float cc[4] = {c4.x, c4.y, c4.z, c4.w}, sn[4] = {s4.x, s4.y, s4.z, s4.w};
#pragma unroll
              for (int j = 0; j < 4; ++j) {
                const float x1 = acc[nt][4 * g + j], x2 = acc[nt][4 * g + j + 8];
                acc[nt][4 * g + j] = x1 * cc[j] - x2 * sn[j];
                acc[nt][4 * g + j + 8] = x1 * sn[j] + x2 * cc[j];
              }
              __builtin_amdgcn_sched_barrier(0);
            }
          }
        }
      } else if (tn < 32 || tn >= 48) {
        do_silu = true;
        dbase = (bfraw*)(P.ws + (tn < 32 ? OFF_GA : OFF_GB)); dR0 = m0; drs = 1024; dC0 = (size_t)((tn < 32 ? tn - 24 : tn - 48) * 128);
      } else if (tn < 36) {
        dbase = (bfraw*)(P.ws + OFF_QB); dR0 = (size_t)(tn - 32) * MT + m0; drs = 128;
      } else {
        const int head = tn - 36;
        scl = 0.08838834764831845f;
        dbase = (bfraw*)(P.ws + OFF_KB); dR0 = (size_t)head * MT + m0; drs = 128;
        bfraw* tp = (bfraw*)(P.ws + OFF_KBT) + (size_t)(head * 128) * MT + perm16(m);
#pragma unroll
        for (int nt = 0; nt < 4; ++nt)
#pragma unroll
          for (int g = 0; g < 4; ++g) {
            const unsigned u0 = pk2(acc[nt][4 * g] * scl, acc[nt][4 * g + 1] * scl);
            const unsigned u1 = pk2(acc[nt][4 * g + 2] * scl, acc[nt][4 * g + 3] * scl);
            const int nl = 32 * nt + 8 * g + 4 * hh;
            tp[(size_t)(nl + 0) * MT] = (bfraw)(u0 & 0xffffu);
            tp[(size_t)(nl + 1) * MT] = (bfraw)(u0 >> 16);
            tp[(size_t)(nl + 2) * MT] = (bfraw)(u1 & 0xffffu);
            tp[(size_t)(nl + 3) * MT] = (bfraw)(u1 >> 16); __builtin_amdgcn_sched_barrier(0);
          }
      }
    } else {
      if (tn < 20) {
        const bool isq = tn < 16;
        const int head = isq ? tn : tn - 16;
        const float* qg = P.qk_norm + eo * 256 + (isq ? 0 : 128);
        dbase = (bfraw*)(P.ws + (isq ? OFF_QC : OFF_KC)); dR0 = (size_t)head * MT + m0; drs = 128;
        scl = isq ? 0.08838834764831845f * LOG2E : 1.f;
        float ss = 0.f;
#pragma unroll
        for (int nt = 0; nt < 4; ++nt)
#pragma unroll
          for (int r = 0; r < 16; ++r) ss += acc[nt][r] * acc[nt][r];
        ss = xsum32(ss);
        const float rstd = rsqrtf(ss * (1.f / 128.f) + EPSN);
#pragma unroll
        for (int nt = 0; nt < 4; ++nt)
#pragma unroll
          for (int g = 0; g < 4; ++g) {
            const f32x4 g4 = *(const f32x4*)(qg + 32 * nt + 8 * g + 4 * hh);
            acc[nt][4 * g] *= rstd * g4.x; acc[nt][4 * g + 1] *= rstd * g4.y;
            acc[nt][4 * g + 2] *= rstd * g4.z; acc[nt][4 * g + 3] *= rstd * g4.w; __builtin_amdgcn_sched_barrier(0);
          }
        if (lat) {
#pragma unroll
          for (int p = 0; p < 2; ++p) {
            const int pos = p ? pcol : prow;
#pragma unroll
            for (int g = 0; g < 4; ++g) {
              const f32x4 c4 = *(const f32x4*)(rope + 8192 + pos * 32 + 8 * g + 4 * hh);
              const f32x4 s4 = *(const f32x4*)(rope + 16384 + pos * 32 + 8 * g + 4 * hh);
              const float cc[4] = {c4.x, c4.y, c4.z, c4.w}, sn[4] = {s4.x, s4.y, s4.z, s4.w};
#pragma unroll
              for (int j = 0; j < 4; ++j) {
                const float x1 = acc[2 * p][4 * g + j], x2 = acc[2 * p + 1][4 * g + j];
                acc[2 * p][4 * g + j] = x1 * cc[j] - x2 * sn[j];
                acc[2 * p + 1][4 * g + j] = x1 * sn[j] + x2 * cc[j];
              }
              __builtin_amdgcn_sched_barrier(0);
            }
          }
        }
      } else {
        do_silu = true;
        dbase = (bfraw*)(P.ws + OFF_GC); dR0 = m0; drs = 2048; dC0 = (size_t)((tn - 24) * 128);
      }
    }
#pragma unroll
    for (int nt = 0; nt < 4; ++nt)
#pragma unroll
      for (int g = 0; g < 4; ++g) {
        float v0 = acc[nt][4 * g], v1 = acc[nt][4 * g + 1], v2 = acc[nt][4 * g + 2], v3 = acc[nt][4 * g + 3];
        if (do_silu) { v0 = siluf(v0); v1 = siluf(v1); v2 = siluf(v2); v3 = siluf(v3); }
        else { v0 *= scl; v1 *= scl; v2 *= scl; v3 *= scl; }
        u32x2 u = {pk2(v0, v1), pk2(v2, v3)};
        pk[nt][g] = u;
      }
    tile_store<false>(lds, pk, dbase, dR0, drs, dC0, dho);
  }
}

template <int D>
DEV void flash_block(const bfraw* Qh, const bfraw* Kh_, const bfraw* Vt_, int q0, int kt0, int nk, bfraw* lds, f32x16 (&O)[4], float& lsum, float& mref, int pmode = 0) {
  const bfraw* Kh = Kh_ + (size_t)kt0 * 64 * D;
  const bfraw* Vt = Vt_ + kt0 * 64;
  constexpr int KS = D + 8;
  constexpr int KT = 64 * KS;
  constexpr int STG = KT + 128 * 72;
  constexpr int KCH = D / 8;
  constexpr int NKC = 64 * KCH / 256;
  const int tid = otid(), lane = tid & 63, w = tid >> 6, l31 = lane & 31, hh = lane >> 5;
  bf16x8 qf[D / 16];
  {
    const bfraw* qp = Qh + (size_t)(q0 + 32 * w + l31) * D + 8 * hh;
#pragma unroll
    for (int s = 0; s < D / 16; ++s) qf[s] = *(const bf16x8*)(qp + 16 * s);
  }
#pragma unroll
  for (int d = 0; d < 4; ++d)
#pragma unroll
    for (int r = 0; r < 16; ++r) O[d][r] = 0.f;
  lsum = 0.f;
  u32x4 rk[NKC], rv[4];
  const int krow = tid / KCH, kcol = (tid % KCH) * 8;
  const int vrow = tid >> 3, vcol = (tid & 7) * 8;
  const unsigned koff = (unsigned)(krow * D + kcol) * 2u, voff = (unsigned)(vrow * MT + vcol) * 2u;
#pragma unroll
  for (int j = 0; j < NKC; ++j) rk[j] = ldg(Kh + (size_t)j * (256 / KCH) * D, koff);
#pragma unroll
  for (int j = 0; j < 4; ++j) rv[j] = ldg(Vt + (size_t)j * 32 * MT, voff);
#pragma unroll
  for (int j = 0; j < NKC; ++j) *(u32x4*)(lds + (krow + j * (256 / KCH)) * KS + kcol) = rk[j];
#pragma unroll
  for (int j = 0; j < 4; ++j) *(u32x4*)(lds + KT + (vrow + 32 * j) * 72 + vcol) = rv[j];
  lds_barrier();
  f32x16 negm;
  {
    f32x16 s0, s1;
#pragma unroll
    for (int r = 0; r < 16; ++r) { s0[r] = 0.f; s1[r] = 0.f; }
#pragma unroll
    for (int s = 0; s < D / 16; ++s) {
      s0 = mfma(*(const bf16x8*)(lds + l31 * KS + 16 * s + 8 * hh), qf[s], s0);
      s1 = mfma(*(const bf16x8*)(lds + (32 + l31) * KS + 16 * s + 8 * hh), qf[s], s1);
    }
    float mx = fmaxf(s0[0], s1[0]);
#pragma unroll
    for (int r = 1; r < 16; ++r) mx = fmaxf(mx, fmaxf(s0[r], s1[r]));
    mx = xmax32(mx);
#pragma unroll
    for (int r = 0; r < 16; ++r) negm[r] = -mx;
  }
  const int ntile = nk >> 6;
  float pm = 0.f;
#pragma unroll 1
  for (int t = 0; t < ntile; ++t) {
    const bfraw* sK = lds + (t & 1) * STG;
    const bfraw* sV = sK + KT;
    if (t + 1 < ntile && !(pmode & 1)) {
      const int key0 = (t + 1) * 64;
#pragma unroll
      for (int j = 0; j < NKC; ++j) rk[j] = ldg(Kh + (size_t)(key0 + j * (256 / KCH)) * D, koff);
#pragma unroll
      for (int j = 0; j < 4; ++j) rv[j] = ldg(Vt + (size_t)j * 32 * MT + key0, voff);
    }
    f32x16 sc[2];
    pm = 0.f;
    {
      constexpr int NS = D / 16;
      constexpr int SL = 16 / NS;
      const bfraw* k0p = sK + l31 * KS + 8 * hh;
      const bfraw* k1p = sK + (32 + l31) * KS + 8 * hh;
      bf16x8 ka[NS], kb[NS];
      ka[0] = *(const bf16x8*)(k0p);
      ka[1] = *(const bf16x8*)(k0p + 16);
      __builtin_amdgcn_s_setprio(1);
#pragma unroll
      for (int s = 0; s < NS; ++s) {
        if (s + 2 < NS) ka[s + 2] = *(const bf16x8*)(k0p + 16 * (s + 2));
        else kb[s + 2 - NS] = *(const bf16x8*)(k1p + 16 * (s + 2 - NS));
        sc[0] = mfma(ka[s], qf[s], s == 0 ? negm : sc[0]);
      }
      __builtin_amdgcn_sched_group_barrier(0x100, 2, 0);
#pragma unroll
      for (int s = 0; s < NS; ++s) {
        __builtin_amdgcn_sched_group_barrier(0x008, 1, 0);
        __builtin_amdgcn_sched_group_barrier(0x100, 1, 0);
      }
      __builtin_amdgcn_s_setprio(0);
      __builtin_amdgcn_sched_barrier(0);
#pragma unroll
      for (int s = 0; s < NS; ++s) {
        if (s + 2 < NS) kb[s + 2] = *(const bf16x8*)(k1p + 16 * (s + 2));
        sc[1] = mfma(kb[s], qf[s], s == 0 ? negm : sc[1]);
#pragma unroll
        for (int r = s * SL; r < (s + 1) * SL; ++r) {
          const float p = fexp2(sc[0][r]);
          sc[0][r] = p;
          lsum += p;
        }
        __builtin_amdgcn_sched_barrier(0);
      }
    }
    bf16x8 vf[4];
#pragma unroll
    for (int d = 0; d < 4; ++d) vf[d] = *(const bf16x8*)(sV + (32 * d + l31) * 72 + 8 * hh);
#pragma unroll
    for (int kt = 0; kt < 2; ++kt) {
#if PROBE_DUP >= 10
      if (pmode & 2) {
#pragma unroll
        for (int r = 0; r < 16; ++r) { sc[kt][r] *= 0.001f; }
      } else
#endif
      if (kt == 1) {
#pragma unroll
      for (int r = 0; r < 16; ++r) {
        const float p = fexp2(sc[kt][r]);
        sc[kt][r] = p;
        lsum += p;
      }
      }
#pragma unroll
      for (int tt = 0; tt < 2; ++tt) {
        const bf16x8 pf = pack8(sc[kt][8 * tt], sc[kt][8 * tt + 1], sc[kt][8 * tt + 2], sc[kt][8 * tt + 3],
                                sc[kt][8 * tt + 4], sc[kt][8 * tt + 5], sc[kt][8 * tt + 6], sc[kt][8 * tt + 7]);
        bf16x8 vn[4];
        if (kt * 2 + tt < 3) {
#pragma unroll
          for (int d = 0; d < 4; ++d) vn[d] = *(const bf16x8*)(sV + (32 * d + l31) * 72 + 16 * (kt * 2 + tt + 1) + 8 * hh);
        }
#if PROBE_DUP >= 10
        if (!(pmode & 4))
#endif
        {
#pragma unroll
        for (int d = 0; d < 4; ++d) O[d] = mfma(vf[d], pf, O[d]);
        }
        if (kt * 2 + tt < 3) {
#pragma unroll
          for (int d = 0; d < 4; ++d) vf[d] = vn[d];
        }
      }
      if ((t & 3) == 3) {
#pragma unroll
        for (int r = 0; r < 16; r += 2) pm = fmaxf(pm, fmaxf(sc[kt][r], sc[kt][r + 1]));
      }
    }
    bool chk = (t & 3) == 3;
    if (chk) { pm = xmax32(pm); chk = __builtin_amdgcn_ballot_w64(pm > 256.f) != 0; }
    if (chk) {
      const bool up = pm > 256.f;
      const float alpha = up ? __builtin_amdgcn_rcpf(pm) : 1.f;
      const float dlt = up ? __builtin_amdgcn_logf(pm) : 0.f;
      lsum *= alpha;
#pragma unroll
      for (int d = 0; d < 4; ++d)
#pragma unroll
        for (int r = 0; r < 16; ++r) O[d][r] *= alpha;
#pragma unroll
      for (int r = 0; r < 16; ++r) negm[r] -= dlt;
    }
    if (t + 1 < ntile && !(pmode & 1)) {
      bfraw* nK = lds + ((t + 1) & 1) * STG;
#pragma unroll
      for (int j = 0; j < NKC; ++j) *(u32x4*)(nK + (krow + j * (256 / KCH)) * KS + kcol) = rk[j];
#pragma unroll
      for (int j = 0; j < 4; ++j) *(u32x4*)(nK + KT + (vrow + 32 * j) * 72 + vcol) = rv[j];
    }
    lds_barrier();
  }
  lsum = xsum32(lsum);
  mref = -negm[0];
}

DEV void chain_item(const Params& P, int e, int it, bfraw* lds) {
  const int tid = otid(), lane = tid & 63, w = tid >> 6, l31 = lane & 31, hh = lane >> 5;
  const int dir = it >> 3, head = (it >> 1) & 3, half = it & 1;
  const float lg2 = -__expf(P.ret_decay[e * 8 + dir * 4 + head]) * LOG2E;
  const float cd = exp2f(lg2 * 64.f);
  bfraw* sQ = lds;
  bfraw* sK = lds + 8704;
  bfraw* sKt = lds + 17408;
  bfraw* sV = lds + 26624;
  const bfraw* Qg = (const bfraw*)(P.ws + OFF_QB) + (size_t)head * MT * 128;
  const bfraw* Kg = (const bfraw*)(P.ws + OFF_KB) + (size_t)head * MT * 128;
  const bfraw* Ktg = (const bfraw*)(P.ws + OFF_KBT) + (size_t)(head * 128) * MT;
  const bfraw* Vg = (const bfraw*)(P.ws + OFF_VTB) + (size_t)(head * 256 + half * 128) * MT;
  float* og = (float*)(P.ws + (dir ? OFF_OB : OFF_OF));
  f32x16 St[4];
  int nrep_c = (PROBE_DUP == 20) ? 2 : 1;
  asm volatile("" : "+s"(nrep_c));
#pragma unroll 1
  for (int rep = 0; rep < nrep_c; ++rep) {
#pragma unroll
  for (int d = 0; d < 4; ++d)
#pragma unroll
    for (int r = 0; r < 16; ++r) St[d][r] = 0.f;
  u32x4 rq[4], rk[4], rkt[4], rv[4];
  const int qrow = tid >> 4, qcol = (tid & 15) * 8;
  const int trow = tid >> 3, tcol = (tid & 7) * 8;
  const unsigned qoff = (unsigned)(qrow * 128 + qcol) * 2u, toff = (unsigned)(trow * MT + tcol) * 2u;
  {
    const int r0 = dir == 0 ? 0 : 192;
#pragma unroll
    for (int j = 0; j < 4; ++j) {
      rkt[j] = ldgu(Ktg + (size_t)(32 * j) * MT + r0, toff);
      rv[j] = ldgu(Vg + (size_t)(32 * j) * MT + r0, toff);
    }
  }
#pragma unroll 1
  for (int n = 0; n < 260; ++n) {
    const int r0 = dir == 0 ? 64 * n : (n < 4 ? 192 - 64 * n : 16576 - 64 * (n - 4));
    const int n1 = n + 1 < 260 ? n + 1 : n;
    const int r1 = dir == 0 ? 64 * n1 : (n1 < 4 ? 192 - 64 * n1 : 16576 - 64 * (n1 - 4));
    float lg2v = lg2;
    int lanev = lane;
    asm volatile("" : "+v"(lg2v), "+v"(lanev));
    const int l31v = lanev & 31, hhv = lanev >> 5;
    lds_barrier();
#pragma unroll
    for (int j = 0; j < 4; ++j) {
      rq[j] = ldgu(Qg + (size_t)(r0 + 16 * j) * 128, qoff);
      rk[j] = ldgu(Kg + (size_t)(r0 + 16 * j) * 128, qoff);
    }
    {
      float kdec[8];
#pragma unroll
      for (int e8 = 0; e8 < 8; ++e8) {
        const int slot = (lanev & 7) * 8 + e8;
        const int orig = perm16(slot);
        kdec[e8] = fexp2(lg2v * (float)(dir == 0 ? 63 - orig : orig));
      }
#pragma unroll
      for (int j = 0; j < 4; ++j) {
        *(u32x4*)(sV + (trow + 32 * j) * 72 + tcol) = rv[j];
        u32x4 u = rkt[j];
        u.x = pk2(bflo(u.x) * kdec[0], bfhi(u.x) * kdec[1]);
        u.y = pk2(bflo(u.y) * kdec[2], bfhi(u.y) * kdec[3]);
        u.z = pk2(bflo(u.z) * kdec[4], bfhi(u.z) * kdec[5]);
        u.w = pk2(bflo(u.w) * kdec[6], bfhi(u.w) * kdec[7]);
        *(u32x4*)(sKt + (trow + 32 * j) * 72 + tcol) = u;
      }
#pragma unroll
      for (int j = 0; j < 4; ++j) {
        *(u32x4*)(sQ + (qrow + 16 * j) * 136 + qcol) = rq[j];
        *(u32x4*)(sK + (qrow + 16 * j) * 136 + qcol) = rk[j];
      }
    }
    lds_barrier();
#pragma unroll
    for (int qt = 0; qt < 2; ++qt) {
      f32x16 O;
#pragma unroll
      for (int r = 0; r < 16; ++r) O[r] = 0.f;
      {
        u32x4 qp8[8];
#pragma unroll
        for (int i = 0; i < 8; ++i) {
          const bfraw* qp = sQ + (32 * qt + l31) * 136 + 16 * i + 4 * hh;
          const u32x2 lo = *(const u32x2*)qp;
          const u32x2 hi = *(const u32x2*)(qp + 8);
          u32x4 u = {lo.x, lo.y, hi.x, hi.y};
          qp8[i] = u;
        }
        __builtin_amdgcn_sched_barrier(0);
#pragma unroll
        for (int dkt = 0; dkt < 4; ++dkt)
#pragma unroll
          for (int tt = 0; tt < 2; ++tt) {
            const bf16x8 af = pack8(St[dkt][8 * tt], St[dkt][8 * tt + 1], St[dkt][8 * tt + 2], St[dkt][8 * tt + 3],
                                    St[dkt][8 * tt + 4], St[dkt][8 * tt + 5], St[dkt][8 * tt + 6], St[dkt][8 * tt + 7]);
            O = mfma(af, __builtin_bit_cast(bf16x8, qp8[dkt * 2 + tt]), O);
          }
      }
      {
        const int offq = 32 * qt + l31v;
        const float qd = fexp2(lg2v * (float)(dir == 0 ? offq + 1 : 64 - offq));
#pragma unroll
        for (int r = 0; r < 16; ++r) O[r] *= qd;
      }
      bf16x8 qf[8];
#pragma unroll
      for (int s = 0; s < 8; ++s) qf[s] = *(const bf16x8*)(sQ + (32 * qt + l31) * 136 + 16 * s + 8 * hh);
#pragma unroll
      for (int kt = 0; kt < 2; ++kt) {
        if (dir == 0 ? (kt <= qt) : (kt >= qt)) {
          bf16x8 kf[8];
#pragma unroll
          for (int s = 0; s < 8; ++s) kf[s] = *(const bf16x8*)(sK + (32 * kt + l31) * 136 + 16 * s + 8 * hh);
          const bf16x8 vf0 = *(const bf16x8*)(sV + (32 * w + l31) * 72 + 32 * kt + 8 * hh);
          const bf16x8 vf1 = *(const bf16x8*)(sV + (32 * w + l31) * 72 + 32 * kt + 16 + 8 * hh);
          __builtin_amdgcn_sched_barrier(0);
          f32x16 sc;
#pragma unroll
          for (int r = 0; r < 16; ++r) sc[r] = 0.f;
#pragma unroll
          for (int s = 0; s < 8; ++s) sc = mfma(kf[s], qf[s], sc);
          const int offq = 32 * qt + l31v;
#pragma unroll
          for (int r = 0; r < 16; ++r) {
            const int offk = 32 * kt + 8 * (r >> 2) + 4 * hhv + (r & 3);
            const int dl = dir == 0 ? offq - offk : offk - offq;
            sc[r] = dl >= 0 ? sc[r] * fexp2(lg2v * (float)dl) : 0.f;
          }
          O = mfma(vf0, pack8(sc[0], sc[1], sc[2], sc[3], sc[4], sc[5], sc[6], sc[7]), O);
          O = mfma(vf1, pack8(sc[8], sc[9], sc[10], sc[11], sc[12], sc[13], sc[14], sc[15]), O);
        }
      }
      float* op = og + (size_t)(r0 + 32 * qt + l31) * 1024 + head * 256 + half * 128 + 32 * w + 4 * hh;
#pragma unroll
      for (int g = 0; g < 4; ++g) {
        f32x4 v = {O[4 * g], O[4 * g + 1], O[4 * g + 2], O[4 * g + 3]};
        *(f32x4*)(op + 8 * g) = v;
      }
    }
    __builtin_amdgcn_sched_barrier(0);
#pragma unroll
    for (int j = 0; j < 4; ++j) {
      rkt[j] = ldgu(Ktg + (size_t)(32 * j) * MT + r1, toff);
      rv[j] = ldgu(Vg + (size_t)(32 * j) * MT + r1, toff);
    }
#pragma unroll
    for (int d = 0; d < 4; ++d)
#pragma unroll
      for (int r = 0; r < 16; ++r) St[d][r] *= cd;
#pragma unroll
    for (int hb = 0; hb < 2; ++hb) {
      bf16x8 vf[2], kf[2][4];
#pragma unroll
      for (int t2 = 0; t2 < 2; ++t2) {
        const int tt = 2 * hb + t2;
        vf[t2] = *(const bf16x8*)(sV + (32 * w + l31) * 72 + 16 * tt + 8 * hh);
#pragma unroll
        for (int dkt = 0; dkt < 4; ++dkt) kf[t2][dkt] = *(const bf16x8*)(sKt + (32 * dkt + l31) * 72 + 16 * tt + 8 * hh);
      }
      __builtin_amdgcn_sched_barrier(0);
#pragma unroll
      for (int t2 = 0; t2 < 2; ++t2)
#pragma unroll
        for (int dkt = 0; dkt < 4; ++dkt) St[dkt] = mfma(kf[t2][dkt], vf[t2], St[dkt]);
    }
  }
  }
  lds_barrier();
}

DEV int next_item(int* ctr, int* s_item) {
  __syncthreads();
  if (otid() == 0) *s_item = atomicAdd(ctr, 1);
  __syncthreads();
  return *s_item;
}

DEV void diff_finish(const Params& P, int e, int layer, int hd, int q0, const f32x16 (&O)[4], float l) {
  int zo = 0;
  asm volatile("" : "+v"(zo));
  const float lambda_init = __builtin_fmaf(-0.6f, __expf(-0.3f * (float)(layer + zo)), 0.8f);
  float s01 = 0.f, s23 = 0.f;
  {
    const float* lp = P.diff_lambda + e * 256 + zo;
    for (int i = 0; i < 64; ++i) { s01 += lp[i] * lp[64 + i]; s23 += lp[128 + i] * lp[192 + i]; }
  }
  const float lam = __expf(s01) - __expf(s23) + lambda_init;
  const float c2 = lam / l;
  float ss = 0.f;
  f32x16 O1[4];
  const float* tmp = (const float*)(P.ws + OFF_DTMP) + (size_t)blockIdx.x * 16384 + (unsigned)otid() * 4u;
#pragma unroll
  for (int d = 0; d < 4; ++d)
#pragma unroll
    for (int g = 0; g < 4; ++g) {
      const f32x4 v = *(const f32x4*)(tmp + (size_t)((d * 4 + g) * 256) * 4);
      const float vv[4] = {v.x, v.y, v.z, v.w};
#pragma unroll
      for (int j = 0; j < 4; ++j) {
        const float o = vv[j] - c2 * O[d][4 * g + j];
        O1[d][4 * g + j] = o;
        ss += o * o;
      }
    }
  ss = xsum32(ss);
  const float rstd = rsqrtf(ss * (1.f / 128.f) + EPSN) * (1.f - lambda_init);
  const int tid = otid(), lane = tid & 63, w = tid >> 6, l31 = lane & 31, hh = lane >> 5;
  const int m = q0 + 32 * w + l31;
  const bfraw* gp = (const bfraw*)(P.ws + OFF_GA) + (size_t)m * 1024 + hd * 128 + 4 * hh;
  bfraw* yp = (bfraw*)(P.ws + OFF_H) + (size_t)m * 2048 + hd * 128 + 4 * hh;
  const float* sg = P.diff_subln + e * 128 + 4 * hh;
#pragma unroll
  for (int d = 0; d < 4; ++d)
#pragma unroll
    for (int g = 0; g < 4; ++g) {
      const f32x4 s4 = *(const f32x4*)(sg + 32 * d + 8 * g);
      const u32x2 gg = *(const u32x2*)(gp + 32 * d + 8 * g);
      const float y0 = O1[d][4 * g] * rstd * s4.x * bflo(gg.x);
      const float y1 = O1[d][4 * g + 1] * rstd * s4.y * bfhi(gg.x);
      const float y2 = O1[d][4 * g + 2] * rstd * s4.z * bflo(gg.y);
      const float y3 = O1[d][4 * g + 3] * rstd * s4.w * bfhi(gg.y);
      u32x2 u = {pk2(y0, y1), pk2(y2, y3)};
      *(u32x2*)(yp + 32 * d + 8 * g) = u; __builtin_amdgcn_sched_barrier(0);
    }
}

constexpr int NSPLIT = 0, KSEG = 10, SEGT = 26;
DEV void phase_attn_even(const Params& P, int layer, unsigned char* smem, int* s_item, int cslot) {
  bfraw* lds = (bfraw*)smem;
  const int e = layer >> 1;
  int* ctr = (int*)(P.ws + OFF_CTR) + layer + cslot;
  const int NCH = 16, NFULL = 8 * 128 - NSPLIT, NSUB = NSPLIT * KSEG, NCX = 8 * 2;
  const int total = NCH + NFULL + NSUB + NCX;
  int itq = next_item(ctr, s_item);
#if PROBE_DUP == 21
  while (itq < NCH) { itq = next_item(ctr, s_item); }
#else
  while (itq < NCH) { chain_item(P, e, itq, lds); itq = next_item(ctr, s_item); }
#endif
  for (;; itq = next_item(ctr, s_item)) {
    if (itq >= total) break;
    int it = itq - NCH;
    int hd, q0, nk, kt0 = 0, sub = -1;
    if (it < NFULL) { hd = it >> 7; q0 = 256 + 128 * (it & 127); nk = MT; }
    else if (it < NFULL + NSUB) {
      sub = it - NFULL;
      const int full = NFULL + sub / KSEG;
      hd = full >> 7; q0 = 256 + 128 * (full & 127); kt0 = (sub % KSEG) * SEGT; nk = SEGT * 64;
    } else { it -= NFULL + NSUB; hd = it >> 1; q0 = 128 * (it & 1); nk = 256; }
    f32x16 O[4];
    float l, mr;
    const bfraw* Vt = (const bfraw*)(P.ws + OFF_VTA) + (size_t)(hd * 128) * MT;
#pragma unroll 1
    for (int a = 0; a < 2; ++a) {
      const bfraw* Qh = (const bfraw*)(P.ws + OFF_QA) + (size_t)(2 * hd + a) * MT * 64;
      const bfraw* Kh = (const bfraw*)(P.ws + OFF_KA) + (size_t)(2 * hd + a) * MT * 64;
      flash_block<64>(Qh, Kh, Vt, q0, kt0, nk, lds, O, l, mr);
      if (sub >= 0) {
        float* pp = (float*)(P.ws + OFF_PART) + (size_t)(sub * 2 + a) * 17 * 1024 + (unsigned)otid() * 4u;
#pragma unroll
        for (int d = 0; d < 4; ++d)
#pragma unroll
          for (int g = 0; g < 4; ++g) {
            f32x4 v = {O[d][4 * g], O[d][4 * g + 1], O[d][4 * g + 2], O[d][4 * g + 3]};
            *(f32x4*)(pp + (size_t)((d * 4 + g) * 1024)) = v;
          }
        f32x4 st = {l, mr, 0.f, 0.f};
        *(f32x4*)(pp + (size_t)16 * 1024) = st;
      } else if (a == 0) {
        const float inv = 1.f / l;
        float* tmp = (float*)(P.ws + OFF_DTMP) + (size_t)blockIdx.x * 16384 + (unsigned)otid() * 4u;
#pragma unroll
        for (int d = 0; d < 4; ++d)
#pragma unroll
          for (int g = 0; g < 4; ++g) {
            f32x4 v = {O[d][4 * g] * inv, O[d][4 * g + 1] * inv, O[d][4 * g + 2] * inv, O[d][4 * g + 3] * inv};
            *(f32x4*)(tmp + (size_t)((d * 4 + g) * 256) * 4) = v;
          }
      }
    }
    if (sub < 0) diff_finish(P, e, layer, hd, q0, O, l);
  }
}

DEV void phase_merge_even(const Params& P, int layer) {
  const int e = layer >> 1;
  for (int j = blockIdx.x; j < NSPLIT; j += gridDim.x) {
    const int full = 8 * 128 - NSPLIT + j;
    const int hd = full >> 7, q0 = 256 + 128 * (full & 127);
    const unsigned to = (unsigned)otid() * 4u;
    f32x16 O[4];
    float l = 1.f;
#pragma unroll 1
    for (int a = 0; a < 2; ++a) {
      const float* pb = (const float*)(P.ws + OFF_PART) + (size_t)(j * KSEG * 2 + a) * 17 * 1024 + to;
      float mmax = -INFINITY;
      for (int sg = 0; sg < KSEG; ++sg) mmax = fmaxf(mmax, (*(const f32x4*)(pb + (size_t)sg * 2 * 17 * 1024 + 16 * 1024)).y);
#pragma unroll
      for (int d = 0; d < 4; ++d)
#pragma unroll
        for (int r = 0; r < 16; ++r) O[d][r] = 0.f;
      float lt = 0.f;
#pragma unroll 1
      for (int sg = 0; sg < KSEG; ++sg) {
        const float* ps = pb + (size_t)sg * 2 * 17 * 1024;
        const f32x4 st = *(const f32x4*)(ps + 16 * 1024);
        const float sc = fexp2(st.y - mmax);
        lt += st.x * sc;
#pragma unroll
        for (int d = 0; d < 4; ++d)
#pragma unroll
          for (int g = 0; g < 4; ++g) {
            const f32x4 v = *(const f32x4*)(ps + (size_t)((d * 4 + g) * 1024));
            O[d][4 * g] += v.x * sc; O[d][4 * g + 1] += v.y * sc; O[d][4 * g + 2] += v.z * sc; O[d][4 * g + 3] += v.w * sc;
          }
      }
      if (a == 0) {
        const float inv = 1.f / lt;
        float* tmp = (float*)(P.ws + OFF_DTMP) + (size_t)blockIdx.x * 16384 + to;
#pragma unroll
        for (int d = 0; d < 4; ++d)
#pragma unroll
          for (int g = 0; g < 4; ++g) {
            f32x4 v = {O[d][4 * g] * inv, O[d][4 * g + 1] * inv, O[d][4 * g + 2] * inv, O[d][4 * g + 3] * inv};
            *(f32x4*)(tmp + (size_t)((d * 4 + g) * 256) * 4) = v;
          }
      } else l = lt;
    }
    diff_finish(P, e, layer, hd, q0, O, l);
  }
}

DEV void phase_attn_odd(const Params& P, int layer, unsigned char* smem, int* s_item, int cslot, int pmode = 0) {
  bfraw* lds = (bfraw*)smem;
  int* ctr = (int*)(P.ws + OFF_CTR) + layer + cslot;
  const int NLAT = 16 * 128, NCX = (layer < 3) ? 16 * 2 : 0;
  const int total = NLAT + NCX;
  for (;;) {
    int it = next_item(ctr, s_item);
    if (it >= total) break;
    int hq, q0, nk;
    if (it < NLAT) { hq = it >> 7; q0 = 256 + 128 * (it & 127); nk = MT; }
    else { it -= NLAT; hq = it >> 1; q0 = 128 * (it & 1); nk = 256; }
    const int kv = hq >> 2;
    f32x16 O[4];
    float l, mr;
    flash_block<128>((const bfraw*)(P.ws + OFF_QC) + (size_t)hq * MT * 128, (const bfraw*)(P.ws + OFF_KC) + (size_t)kv * MT * 128,
                     (const bfraw*)(P.ws + OFF_VTC) + (size_t)(kv * 128) * MT, q0, 0, nk, lds, O, l, mr, pmode);
    if (pmode) { if (l == 12345.678f) ((float*)(P.ws + OFF_DTMP))[0] = O[0][0] + O[1][1] + O[2][2] + O[3][3] + mr; continue; }
    const float inv = 1.f / l;
    const int tid = otid(), lane = tid & 63, w = tid >> 6, l31 = lane & 31, hh = lane >> 5;
    const int m = q0 + 32 * w + l31;
    const bfraw* gp = (const bfraw*)(P.ws + OFF_GC) + (size_t)m * 2048 + hq * 128 + 4 * hh;
    bfraw* yp = (bfraw*)(P.ws + OFF_H) + (size_t)m * 2048 + hq * 128 + 4 * hh;
#pragma unroll
    for (int d = 0; d < 4; ++d)
#pragma unroll
      for (int g = 0; g < 4; ++g) {
        const u32x2 gg = *(const u32x2*)(gp + 32 * d + 8 * g);
        const float y0 = O[d][4 * g] * inv * bflo(gg.x);
        const float y1 = O[d][4 * g + 1] * inv * bfhi(gg.x);
        const float y2 = O[d][4 * g + 2] * inv * bflo(gg.y);
        const float y3 = O[d][4 * g + 3] * inv * bfhi(gg.y);
        u32x2 u = {pk2(y0, y1), pk2(y2, y3)};
        *(u32x2*)(yp + 32 * d + 8 * g) = u; __builtin_amdgcn_sched_barrier(0);
      }
  }
}

DEV void phase_comb(const Params& P, int e) {
  const int tid = otid(), lane = tid & 63, w = tid >> 6;
  const float* OFp = (const float*)(P.ws + OFF_OF);
  const float* OBp = (const float*)(P.ws + OFF_OB);
  const bfraw* GB = (const bfraw*)(P.ws + OFF_GB);
  bfraw* Y = (bfraw*)(P.ws + OFF_H);
  f32x4 g4[4];
#pragma unroll
  for (int h = 0; h < 4; ++h) g4[h] = *(const f32x4*)(P.ret_gn + e * 1024 + h * 256 + lane * 4);
  for (int m = blockIdx.x * 4 + w; m < MT; m += gridDim.x * 4) {
    f32x4 z[4];
    u32x2 gg[4];
#pragma unroll
    for (int h = 0; h < 4; ++h) {
      const size_t o = (size_t)m * 1024 + h * 256 + lane * 4;
      z[h] = *(const f32x4*)(OFp + o) + *(const f32x4*)(OBp + o);
      gg[h] = *(const u32x2*)(GB + o);
    }
    float s1[4];
#pragma unroll
    for (int h = 0; h < 4; ++h) s1[h] = z[h].x + z[h].y + z[h].z + z[h].w;
#pragma unroll
    for (int o = 1; o < 64; o <<= 1)
#pragma unroll
      for (int h = 0; h < 4; ++h) s1[h] += __int_as_float(__builtin_amdgcn_ds_bpermute((lane ^ o) << 2, __float_as_int(s1[h])));
    float s2[4];
#pragma unroll
    for (int h = 0; h < 4; ++h) {
      z[h] -= s1[h] * (1.f / 256.f);
      s2[h] = z[h].x * z[h].x + z[h].y * z[h].y + z[h].z * z[h].z + z[h].w * z[h].w;
    }
#pragma unroll
    for (int o = 1; o < 64; o <<= 1)
#pragma unroll
      for (int h = 0; h < 4; ++h) s2[h] += __int_as_float(__builtin_amdgcn_ds_bpermute((lane ^ o) << 2, __float_as_int(s2[h])));
#pragma unroll
    for (int h = 0; h < 4; ++h) {
      const float rstd = rsqrtf(s2[h] * (1.f / 256.f) + EPSN);
      u32x2 u = {pk2(z[h].x * rstd * g4[h].x * bflo(gg[h].x), z[h].y * rstd * g4[h].y * bfhi(gg[h].x)),
                 pk2(z[h].z * rstd * g4[h].z * bflo(gg[h].y), z[h].w * rstd * g4[h].w * bfhi(gg[h].y))};
      *(u32x2*)(Y + (size_t)m * 2048 + 1024 + h * 256 + lane * 4) = u;
    }
  }
}

DEV void stamp(const Params& P, int i) {
#if PROBE_TSA >= 0
  if (blockIdx.x == 0 && otid() == 0) ((unsigned long long*)(P.ws + OFF_BAR + 14336))[i] = wall_clock64();
#endif
}
__global__ void __launch_bounds__(256, 2) mega(Params P) {
  cg::grid_group grid = cg::this_grid();
  __shared__ __attribute__((aligned(16))) unsigned char smem[73728];
  __shared__ int s_item;
  __shared__ __attribute__((aligned(16))) unsigned xb_words[4];
  if (P.ws == nullptr) grid.sync();
  if (otid() == 0) { xb_words[0] = 0u; xb_words[1] = 0u; xb_words[2] = 0u; xb_words[3] = 0u; }
  __syncthreads();
  const XcdBarrier xb = xcd_barrier_post((unsigned*)(P.ws + OFF_BAR), (volatile LAS unsigned*)xb_words);
  stamp(P, 0);
  {
    int nsy = (PROBE_DUP == 32) ? 16 : 0;
    asm volatile("" : "+s"(nsy));
#pragma unroll 1
    for (int rep = 0; rep < nsy; ++rep) xcd_barrier(xb);
  }
#if PROBE_DUP == 34 || PROBE_DUP == 35
  {
    const f32x4* src = (const f32x4*)P.w_mod;
    const size_t n4 = (size_t)4 * 2048 * 6144 / 4;
    f32x4 acc = {0.f, 0.f, 0.f, 0.f};
    const int npass = (PROBE_DUP == 35) ? 3 : 1;
    for (int pass = 0; pass < npass; ++pass)
    for (size_t i = (size_t)blockIdx.x * 256 + otid(); i < n4; i += (size_t)gridDim.x * 256 * 8) {
#pragma unroll
      for (int u = 0; u < 8; ++u) { const size_t k = i + (size_t)u * gridDim.x * 256; if (k < n4) acc += src[k]; }
    }
    if (acc.x + acc.y + acc.z + acc.w == 1.2345e-30f) ((float*)(P.ws + OFF_DTMP))[0] = acc.x;
    xcd_barrier(xb);
  }
#endif
  {
    int nrep_0 = (PROBE_DUP == 30) ? 2 : 1;
    asm volatile("" : "+s"(nrep_0));
#pragma unroll 1
    for (int rep = 0; rep < nrep_0; ++rep) {
      phase0(P, smem);
      xcd_barrier(xb);
      phase0b(P);
      xcd_barrier(xb);
    }
  }
  stamp(P, 1);
#pragma unroll 1
  for (int layer = 0; layer < 4; ++layer) {
    {
      int nrep_n = (PROBE_DUP == 31) ? 2 : 1;
      asm volatile("" : "+s"(nrep_n));
#pragma unroll 1
      for (int rep = 0; rep < nrep_n; ++rep) {
        phase_norm(P, layer);
#if PROBE_DUP == 33
        for (int r2 = 0; r2 < 8; ++r2) { __syncthreads(); phase_norm(P, layer); }
#endif
        xcd_barrier(xb);
      }
    }
    stamp(P, 2 + 5 * layer);
    int nrep_g = (PROBE_DUP == 2) ? 2 : 1, nrep_a = (PROBE_DUP == 1 || (PROBE_DUP == 3 && !(layer & 1)) || ((PROBE_DUP == 4 || PROBE_DUP >= 10) && (layer & 1))) ? 2 : 1;
    asm volatile("" : "+s"(nrep_g), "+s"(nrep_a));
#pragma unroll 1
    for (int rep = 0; rep < nrep_g; ++rep) {
      phase_gemm(P, layer, layer & 1, smem);
      xcd_barrier(xb);
    }
    stamp(P, 3 + 5 * layer);
#pragma unroll 1
    for (int rep = 0; rep < nrep_a; ++rep) {
      if (layer & 1) phase_attn_odd(P, layer, smem, &s_item, 4 * rep, (PROBE_DUP >= 10 && rep + 1 < nrep_a) ? (PROBE_DUP - 10) | 8 : 0);
      else {
#if PROBE_DUP == 21
        if (blockIdx.x < 16) chain_item(P, layer >> 1, blockIdx.x, (bfraw*)smem);
        xcd_barrier(xb);
#endif
        phase_attn_even(P, layer, smem, &s_item, 4 * rep);
      }
      if (rep + 1 < nrep_a) xcd_barrier(xb);
    }
    if (!(layer & 1)) {
      xcd_barrier(xb);
      stamp(P, 4 + 5 * layer);
      phase_comb(P, layer >> 1);
      phase_merge_even(P, layer);
    }
    xcd_barrier(xb);
    stamp(P, 5 + 5 * layer);
    phase_gemm(P, layer, 2, smem);
    xcd_barrier(xb);
    stamp(P, 6 + 5 * layer);
  }
  phase_final(P);
}

extern "C" void kernel_launch(void* const* d_in, const int* in_sizes, int n_in, void* d_out, int out_size, void* d_ws,
                              size_t ws_size, hipStream_t stream) {
  static int grid_blocks = 0;
  if (grid_blocks == 0) {
    if (n_in != 17 || ws_size < WS_END) {
      fprintf(stderr, "kernel_launch: need 17 inputs and >= %zu bytes of workspace; got %d inputs, %zu bytes\n", (size_t)WS_END, n_in, ws_size);
      grid_blocks = -1;
      return;
    }
    int dev = 0, cus = 0, per_cu = 0;
    hipGetDevice(&dev);
    hipDeviceGetAttribute(&cus, hipDeviceAttributeMultiprocessorCount, dev);
    hipOccupancyMaxActiveBlocksPerMultiprocessor(&per_cu, (const void*)mega, 256, 0);
    if (per_cu > 2) per_cu = 2;
    if (per_cu < 1) per_cu = 1;
    grid_blocks = cus * per_cu;
  }
  if (grid_blocks < 0) return;
  Params p{};
  p.x = (const float*)d_in[0]; p.c = (const float*)d_in[1]; p.ctx = (const float*)d_in[2]; p.c_ctx = (const float*)d_in[3];
  p.norm_g = (const float*)d_in[4]; p.w_mod = (const float*)d_in[5]; p.b_mod = (const float*)d_in[6];
  p.ev_w_in = (const float*)d_in[7]; p.ev_w_out = (const float*)d_in[8]; p.diff_lambda = (const float*)d_in[9];
  p.diff_subln = (const float*)d_in[10]; p.ret_decay = (const float*)d_in[11]; p.ret_gn = (const float*)d_in[12];
  p.od_w_in = (const float*)d_in[13]; p.od_w_out = (const float*)d_in[14]; p.qk_norm = (const float*)d_in[15];
  p.final_norm = (const float*)d_in[16];
  p.out = (float*)d_out; p.ws = (unsigned char*)d_ws;
  (void)hipMemsetAsync((unsigned char*)d_ws + OFF_BAR, 0, 16384, stream);
  void* args[] = {&p};
  hipError_t e = hipLaunchCooperativeKernel((const void*)mega, dim3(grid_blocks), dim3(256), args, 0, stream);
  if (e != hipSuccess) fprintf(stderr, "cooperative launch failed: %s (grid %d)\n", hipGetErrorString(e), grid_blocks);
}
```
